# Optimizing an MI355X kernel written in HIP

```python
import math
import jax
import jax.numpy as jnp
from jax import lax
import numpy as np

D_MODEL = 2048
BATCH = 8
SEQ = 4096
DEPTH = 4

CHUNK = 64
N_MIXERS = 4
D_MIX = D_MODEL
D_GROUP = D_MIX // N_MIXERS

HG_DIM = 128
HG_HEADS = D_GROUP // HG_DIM

S5_CH = 16
S5_GROUPS = D_GROUP // S5_CH
S5_STATE = 64
S5_DT_MIN = 1e-3
S5_DT_MAX = 1e-1

SB_DIM = 128
SB_HEADS = D_GROUP // SB_DIM
Q_BLOCK = 128

RW_DIM = 64
RW_HEADS = D_GROUP // RW_DIM
RW_W_RANK = 64
RW_A_RANK = 64
RW_G_RANK = 128
RW_GN_EPS = 64e-5
RW_SIZES = (D_GROUP, D_GROUP, D_GROUP, RW_W_RANK, RW_A_RANK, RW_G_RANK)
RW_SPLITS = tuple(int(s) for s in np.cumsum(RW_SIZES)[:-1])
RW_WIDTH = sum(RW_SIZES)
RW_OFFSET = 8 * D_GROUP
N_IN = RW_OFFSET + RW_WIDTH

D_FF = 256 * math.ceil(8 * D_MODEL / 3 / 256)
DEEPNORM_ALPHA = (2 * DEPTH) ** 0.25
DEEPNORM_BETA = (8 * DEPTH) ** -0.25
LN_EPS = 1e-5
RMS_EPS = 1e-6

kernel_name = 'hybrid_stream_encoder_hgrn2_s5_sb_rwkv7'


def _layer_norm(x, g, b):
    xf = x.astype(jnp.float32)
    mu = jnp.mean(xf, -1, keepdims=True)
    var = jnp.mean(jnp.square(xf - mu), -1, keepdims=True)
    y = (xf - mu) * lax.rsqrt(var + LN_EPS)
    return (y * g.astype(jnp.float32) + b.astype(jnp.float32)).astype(x.dtype)


def _rms_norm(xf):
    return xf * lax.rsqrt(jnp.mean(xf * xf, -1, keepdims=True) + RMS_EPS)


def _token_shift(x, mu):
    prev = jnp.pad(x, ((0, 0), (1, 0), (0, 0)))[:, :-1]
    return x + mu * (prev - x)


def _hgrn2(q, f_logit, i, g, lb, norm_g):
    B, S, _ = q.shape
    f32 = jnp.float32
    n_chunks = S // CHUNK
    lbf = lb.astype(f32)
    log_f = jnp.logaddexp(jnp.log(jnp.maximum(lbf, 0.0)),
                          jnp.log1p(-lbf) + jax.nn.log_sigmoid(f_logit.astype(f32)))
    k = -jnp.expm1(log_f)
    qf = jax.nn.silu(q.astype(f32))
    v = i.astype(f32)

    def to_chunks(t):
        return t.reshape(B, n_chunks, CHUNK, HG_HEADS, HG_DIM).transpose(1, 0, 3, 2, 4)

    causal = jnp.tril(jnp.ones((CHUNK, CHUNK), bool))[:, :, None]

    def step(state, inp):
        qb, kb, vb, lfb = inp
        bcum = jnp.cumsum(lfb, axis=-2)
        diff = bcum[..., :, None, :] - bcum[..., None, :, :]
        decay = jnp.exp(jnp.where(causal, diff, -jnp.inf))
        scores = jnp.einsum('bhtk,bhsk,bhtsk->bhts', qb, kb, decay)
        o = (jnp.einsum('bhts,bhsv->bhtv', scores, vb)
             + jnp.einsum('bhtk,bhkv->bhtv', qb * jnp.exp(bcum), state))
        b_last = bcum[..., -1:, :]
        state = (jnp.exp(b_last[..., 0, :])[..., None] * state
                 + jnp.einsum('bhsk,bhsv->bhkv', kb * jnp.exp(b_last - bcum), vb))
        return state, o

    s0 = jnp.zeros((B, HG_HEADS, HG_DIM, HG_DIM), f32)
    _, o = lax.scan(step, s0, (to_chunks(qf), to_chunks(k), to_chunks(v), to_chunks(log_f)))
    o = o.transpose(1, 0, 3, 2, 4).reshape(B, S, HG_HEADS, HG_DIM)
    o = _rms_norm(o).reshape(B, S, D_GROUP) * norm_g.astype(f32)
    return (o * jax.nn.silu(g.astype(f32))).astype(q.dtype)


def _s5(u, a_re, a_im, log_dt, b_re, b_im, c_re, c_im, d_skip, glu_w, glu_b):
    B, S, _ = u.shape
    f32 = jnp.float32
    uf = u.astype(f32)
    ug = uf.reshape(B, S, S5_GROUPS, S5_CH)
    dt = jnp.exp(log_dt.astype(f32))[:, None]
    ar, ai = a_re.astype(f32), a_im.astype(f32)
    mag = jnp.exp(ar * dt)
    lr, li = mag * jnp.cos(ai * dt), mag * jnp.sin(ai * dt)
    den = ar * ar + ai * ai
    zr = ((lr - 1.0) * ar + li * ai) / den
    zi = (li * ar - (lr - 1.0) * ai) / den
    br, bi = b_re.astype(f32), b_im.astype(f32)
    bbar_r = zr[..., None] * br - zi[..., None] * bi
    bbar_i = zr[..., None] * bi + zi[..., None] * br
    xr = jnp.einsum('bsgc,gpc->bsgp', ug, bbar_r)
    xi = jnp.einsum('bsgc,gpc->bsgp', ug, bbar_i)
    lam_r = jnp.broadcast_to(lr[None, None], (1, S, S5_GROUPS, S5_STATE))
    lam_i = jnp.broadcast_to(li[None, None], (1, S, S5_GROUPS, S5_STATE))

    def combine(e1, e2):
        a1r, a1i, b1r, b1i = e1
        a2r, a2i, b2r, b2i = e2
        return (a2r * a1r - a2i * a1i, a2r * a1i + a2i * a1r,
                a2r * b1r - a2i * b1i + b2r, a2r * b1i + a2i * b1r + b2i)

    _, _, hr, hi = lax.associative_scan(combine, (lam_r, lam_i, xr, xi), axis=1)
    y = (jnp.einsum('bsgp,gcp->bsgc', hr, c_re.astype(f32))
         - jnp.einsum('bsgp,gcp->bsgc', hi, c_im.astype(f32)))
    y = y.reshape(B, S, D_GROUP) + d_skip.astype(f32) * uf
    y = jax.nn.gelu(y)
    y = y * jax.nn.sigmoid(y @ glu_w.astype(f32) + glu_b.astype(f32))
    return y.astype(u.dtype)


def _stick_breaking(q, k, v):
    B, S, _ = q.shape
    f32 = jnp.float32

    def heads(t):
        return t.astype(f32).reshape(B, S, SB_HEADS, SB_DIM).transpose(0, 2, 1, 3)

    qh, kh, vh = heads(q) * (SB_DIM ** -0.5), heads(k), heads(v)
    n_blk = S // Q_BLOCK
    q_blocks = qh.reshape(B, SB_HEADS, n_blk, Q_BLOCK, SB_DIM).transpose(2, 0, 1, 3, 4)
    key_pos = jnp.arange(S)

    def block(args):
        qb, start = args
        z = jnp.einsum('bhtd,bhsd->bhts', qb, kh)
        q_pos = start + jnp.arange(Q_BLOCK)
        mask = key_pos[None, :] < q_pos[:, None]
        log_rest = jnp.where(mask, jax.nn.log_sigmoid(-z), 0.0)
        after = lax.cumsum(log_rest, axis=3, reverse=True) - log_rest
        w = jnp.where(mask, jnp.exp(jax.nn.log_sigmoid(z) + after), 0.0)
        return jnp.einsum('bhts,bhsd->bhtd', w, vh)

    o = lax.map(block, (q_blocks, jnp.arange(n_blk) * Q_BLOCK))
    return o.transpose(1, 0, 3, 2, 4).reshape(B, S, D_GROUP).astype(q.dtype)


def _rwkv7(r, k, v, xw, xa, xg, w0, w2, a0, a2, g2, k_k, k_a, r_k, gn_g, gn_b):
    B, S, _ = r.shape
    f32 = jnp.float32
    w_log = -jax.nn.softplus(-(w0 + jnp.tanh(xw) @ w2).astype(f32)) - 0.5
    decay = jnp.exp(-jnp.exp(w_log))
    a = jax.nn.sigmoid((a0 + xa @ a2).astype(f32))
    g = (jax.nn.sigmoid(xg) @ g2).astype(f32)

    def heads(t):
        return t.astype(f32).reshape(B, S, RW_HEADS, RW_DIM)

    rh, kh, vh, dh, ah = heads(r), heads(k), heads(v), heads(decay), heads(a)
    kk = kh * k_k.astype(f32).reshape(RW_HEADS, RW_DIM)
    kk = kk * lax.rsqrt(jnp.maximum(jnp.sum(kk * kk, -1, keepdims=True), 1e-24))
    kh = kh * (1.0 + (ah - 1.0) * k_a.astype(f32).reshape(RW_HEADS, RW_DIM))

    def step(state, inp):
        rt, wt, kt, vt, kkt, at = inp
        removed = jnp.einsum('bhvk,bhk->bhv', state, kkt)
        state = (state * wt[:, :, None, :]
                 - removed[..., None] * (kkt * at)[:, :, None, :]
                 + vt[..., None] * kt[:, :, None, :])
        return state, jnp.einsum('bhvk,bhk->bhv', state, rt)

    s0 = jnp.zeros((B, RW_HEADS, RW_DIM, RW_DIM), f32)
    xs = tuple(jnp.moveaxis(t, 1, 0) for t in (rh, dh, kh, vh, kk, ah))
    _, out = lax.scan(step, s0, xs)
    out = jnp.moveaxis(out, 0, 1)
    mu = jnp.mean(out, -1, keepdims=True)
    var = jnp.mean(jnp.square(out - mu), -1, keepdims=True)
    out = ((out - mu) * lax.rsqrt(var + RW_GN_EPS)).reshape(B, S, D_GROUP)
    out = out * gn_g.astype(f32) + gn_b.astype(f32)
    bonus = jnp.sum(rh * kh * r_k.astype(f32), -1, keepdims=True) * vh
    out = (out + bonus.reshape(B, S, D_GROUP)) * g
    return out.astype(r.dtype)


def setup_inputs(seed: int = 0) -> dict:
    key = jax.random.key(seed)
    ks = iter(jax.random.split(key, 48))
    f32 = jnp.float32
    L = DEPTH

    def nrm(shape, scale):
        return scale * jax.random.normal(next(ks), shape, f32)

    n_idx = jnp.arange(S5_STATE, dtype=f32)
    return {
        'x': nrm((BATCH, SEQ, D_MODEL), 1.0),
        'c': nrm((BATCH, D_MODEL), 1.0),
        'ada_w': nrm((L, D_MODEL, 6 * D_MODEL), 0.5 * D_MODEL ** -0.5),
        'ada_b': nrm((L, 6 * D_MODEL), 0.01),
        'w_in': nrm((L, D_MODEL, N_IN), D_MODEL ** -0.5),
        'w_out': nrm((L, D_MIX, D_MODEL), DEEPNORM_BETA * D_MIX ** -0.5),
        'hg_lb_logits': nrm((L, D_GROUP), 0.5),
        'hg_norm_g': 1.0 + nrm((L, D_GROUP), 0.02),
        's5_a_re': -0.5 + nrm((L, S5_GROUPS, S5_STATE), 0.01),
        's5_a_im': math.pi * n_idx + nrm((L, S5_GROUPS, S5_STATE), 0.01),
        's5_log_dt': jax.random.uniform(next(ks), (L, S5_GROUPS), f32,
                                        math.log(S5_DT_MIN), math.log(S5_DT_MAX)),
        's5_b_re': nrm((L, S5_GROUPS, S5_STATE, S5_CH), (2 * S5_CH) ** -0.5),
        's5_b_im': nrm((L, S5_GROUPS, S5_STATE, S5_CH), (2 * S5_CH) ** -0.5),
        's5_c_re': nrm((L, S5_GROUPS, S5_CH, S5_STATE), S5_STATE ** -0.5),
        's5_c_im': nrm((L, S5_GROUPS, S5_CH, S5_STATE), S5_STATE ** -0.5),
        's5_d': nrm((L, D_GROUP), 1.0),
        's5_glu_w': nrm((L, D_GROUP, D_GROUP), D_GROUP ** -0.5),
        's5_glu_b': nrm((L, D_GROUP), 0.01),
        'rw_mu': jax.random.uniform(next(ks), (L, RW_WIDTH), f32),
        'rw_w0': nrm((L, D_GROUP), 1.0),
        'rw_w2': nrm((L, RW_W_RANK, D_GROUP), 0.1 * RW_W_RANK ** -0.5),
        'rw_a0': nrm((L, D_GROUP), 0.5),
        'rw_a2': nrm((L, RW_A_RANK, D_GROUP), 0.1 * RW_A_RANK ** -0.5),
        'rw_g2': nrm((L, RW_G_RANK, D_GROUP), RW_G_RANK ** -0.5),
        'rw_k_k': 0.85 + nrm((L, D_GROUP), 0.02),
        'rw_k_a': 1.0 + nrm((L, D_GROUP), 0.02),
        'rw_r_k': nrm((L, RW_HEADS, RW_DIM), 0.1),
        'rw_gn_g': 1.0 + nrm((L, D_GROUP), 0.02),
        'rw_gn_b': nrm((L, D_GROUP), 0.01),
        'ln1_g': 1.0 + nrm((L, D_MODEL), 0.02),
        'ln1_b': nrm((L, D_MODEL), 0.01),
        'ffn_w1': nrm((L, D_MODEL, D_FF), D_MODEL ** -0.5),
        'ffn_w3': nrm((L, D_MODEL, D_FF), D_MODEL ** -0.5),
        'ffn_w2': nrm((L, D_FF, D_MODEL), DEEPNORM_BETA * D_FF ** -0.5),
        'ln2_g': 1.0 + nrm((L, D_MODEL), 0.02),
        'ln2_b': nrm((L, D_MODEL), 0.01),
    }


def reference(x, c, ada_w, ada_b, w_in, w_out, hg_lb_logits, hg_norm_g,
              s5_a_re, s5_a_im, s5_log_dt, s5_b_re, s5_b_im, s5_c_re, s5_c_im,
              s5_d, s5_glu_w, s5_glu_b,
              rw_mu, rw_w0, rw_w2, rw_a0, rw_a2, rw_g2, rw_k_k, rw_k_a, rw_r_k,
              rw_gn_g, rw_gn_b,
              ln1_g, ln1_b, ffn_w1, ffn_w3, ffn_w2, ln2_g, ln2_b):
    lb_all = jnp.cumsum(jax.nn.softmax(hg_lb_logits.astype(jnp.float32), axis=0), axis=0)
    lb_all = lb_all - lb_all[:1]
    c_act = jax.nn.silu(c)
    for l in range(DEPTH):
        mod = c_act @ ada_w[l] + ada_b[l]
        shift1, scale1, gate1, shift2, scale2, gate2 = [m[:, None, :] for m in jnp.split(mod, 6, axis=-1)]

        h = x * (1.0 + scale1) + shift1
        proj = h @ w_in[l]
        hg_q, hg_f, hg_i, hg_g, s5_u, sb_q, sb_k, sb_v = jnp.split(proj[..., :RW_OFFSET], 8, axis=-1)
        rw = _token_shift(proj[..., RW_OFFSET:], rw_mu[l])
        rw_r, rw_k, rw_v, rw_xw, rw_xa, rw_xg = jnp.split(rw, RW_SPLITS, axis=-1)
        o_a = _hgrn2(hg_q, hg_f, hg_i, hg_g, lb_all[l], hg_norm_g[l])
        o_b = _s5(s5_u, s5_a_re[l], s5_a_im[l], s5_log_dt[l], s5_b_re[l], s5_b_im[l],
                  s5_c_re[l], s5_c_im[l], s5_d[l], s5_glu_w[l], s5_glu_b[l])
        o_c = _stick_breaking(sb_q, sb_k, sb_v)
        o_d = _rwkv7(rw_r, rw_k, rw_v, rw_xw, rw_xa, rw_xg, rw_w0[l], rw_w2[l], rw_a0[l],
                     rw_a2[l], rw_g2[l], rw_k_k[l], rw_k_a[l], rw_r_k[l], rw_gn_g[l], rw_gn_b[l])
        mix = jnp.concatenate([o_a, o_b, o_c, o_d], axis=-1) @ w_out[l]
        x = _layer_norm(DEEPNORM_ALPHA * x + gate1 * mix, ln1_g[l], ln1_b[l])

        h = x * (1.0 + scale2) + shift2
        ffn = (jax.nn.silu(h @ ffn_w1[l]) * (h @ ffn_w3[l])) @ ffn_w2[l]
        x = _layer_norm(DEEPNORM_ALPHA * x + gate2 * ffn, ln2_g[l], ln2_b[l])
    return x
```

```cpp
#include <hip/hip_runtime.h>
#include <cstdio>
#include <cstdint>

#ifndef MK_LAUNCH_MODE
#define MK_LAUNCH_MODE 1
#endif

#ifndef PH_ENABLE
#define PH_ENABLE 0xFFFFF
#endif
#define PHE(k) (((PH_ENABLE) >> (k)) & 1)
#define LAS __attribute__((address_space(3)))
typedef _Float16 h16;
typedef _Float16 half8 __attribute__((ext_vector_type(8)));
typedef _Float16 half4 __attribute__((ext_vector_type(4)));
typedef _Float16 half2v __attribute__((ext_vector_type(2)));
typedef float f32x4 __attribute__((ext_vector_type(4)));
typedef float f32x2 __attribute__((ext_vector_type(2)));
typedef unsigned u32x4 __attribute__((ext_vector_type(4)));
typedef unsigned u32x2 __attribute__((ext_vector_type(2)));

constexpr int BATCH = 8, SEQ = 4096, DM = 2048, DEPTH = 4, M = BATCH * SEQ;
constexpr int DG = 512, NIN = 5888, RWOFF = 4096, DFF = 5632;
constexpr int MODW = 6 * DM;
constexpr float DN_ALPHA = 1.681792830507429f;
constexpr float LN_EPS = 1e-5f, RMS_EPS = 1e-6f, GN_EPS = 64e-5f;
constexpr int S5L = 32, S5NC = M / S5L;
constexpr int S5K3 = 640;

constexpr size_t MiB = 1u << 20;
constexpr size_t WS_CTL = 0, CTL_ZERO_BYTES = 64 * 1024;
constexpr size_t WS_MOD = 1 * MiB;
constexpr size_t WS_LB = 3 * MiB;
constexpr size_t WS_W16 = 16 * MiB;
constexpr size_t WS_WIN = WS_W16;
constexpr size_t WS_WOUT = WS_WIN + 23 * MiB;
constexpr size_t WS_W13 = WS_WOUT + 8 * MiB;
constexpr size_t WS_W2 = WS_W13 + 44 * MiB;
constexpr size_t WS_GLU = WS_W2 + 22 * MiB;
constexpr size_t WS_LRT = WS_GLU + 1 * MiB;
constexpr size_t WS_S5T3 = WS_LRT + 1 * MiB;
constexpr size_t WS_S5T1 = WS_S5T3 + 20 * MiB;
constexpr size_t WS_X = 152 * MiB;
constexpr size_t WS_H16 = 408 * MiB;
constexpr size_t WS_PROJ = 536 * MiB;
constexpr size_t WS_RWA = 904 * MiB;
constexpr size_t WS_HLOC = 920 * MiB;
constexpr size_t WS_Y16 = 904 * MiB;
constexpr size_t WS_RWW = 936 * MiB;
constexpr size_t WS_LR16 = 1000 * MiB;
constexpr size_t WS_RWA16 = 1096 * MiB;
constexpr size_t WS_RWKK = 1128 * MiB;
constexpr size_t WS_RWKP = 1160 * MiB;
constexpr size_t WS_RWR = 1192 * MiB;
constexpr size_t WS_RWV = 1224 * MiB;
constexpr size_t WS_HGK = 1256 * MiB;
constexpr size_t WS_HGQ = 1288 * MiB;
constexpr size_t WS_HGRAW = 1320 * MiB;
constexpr size_t WS_UG = 1352 * MiB;
constexpr size_t WS_RWRAW = 1352 * MiB;
constexpr size_t WS_END = 1392 * MiB;
static_assert(WS_S5T1 + 8 * MiB <= WS_X, "W16 map");
constexpr int CW_BAR = 1024;

constexpr int RING_BYTES = 131072, MISC_OFF = RING_BYTES + 64, LDS_BYTES = 147456;
constexpr int NWAVES = 8;

#define DI __device__ __forceinline__
DI int opq_lane() { int l; asm volatile("v_mbcnt_lo_u32_b32 %0, -1, 0\n\tv_mbcnt_hi_u32_b32 %0, -1, %0" : "=v"(l)); return l; }
DI unsigned pkh(float a, float b) { half2v h; h.x = (h16)a; h.y = (h16)b; return __builtin_bit_cast(unsigned, h); }
DI float sigmoidf_(float x) { return __builtin_amdgcn_rcpf(1.f + __expf(-x)); }
DI float siluf_(float x) { return x * sigmoidf_(x); }
DI float tanhf_(float x) { const float t = __expf(-2.f * fabsf(x)); const float r = (1.f - t) * __builtin_amdgcn_rcpf(1.f + t); return x < 0.f ? -r : r; }
DI float softplusf_(float x) { return fmaxf(x, 0.f) + 0.6931471805599453f * __builtin_amdgcn_logf(1.f + __expf(-fabsf(x))); }
DI float rsqrtf_(float x) { return __builtin_amdgcn_rsqf(x); }
DI float gelu_tanhf_(float y) { const float u = 1.5957691216057308f * (y + 0.044715f * y * y * y); return y * sigmoidf_(u); }
template <int CTRL> DI float dppf(float v) { return __builtin_bit_cast(float, __builtin_amdgcn_update_dpp(0, __builtin_bit_cast(int, v), CTRL, 0xf, 0xf, false)); }
DI float sum4(float v) { v += dppf<0xB1>(v); v += dppf<0x4E>(v); return v; }
DI float sum8(float v) { v = sum4(v); v += dppf<0x141>(v); return v; }
DI float sum16(float v) { v = sum8(v); v += dppf<0x140>(v); return v; }
DI float wave_sum(float v) {
#pragma unroll
    for (int o = 1; o < 64; o <<= 1) v += __shfl_xor(v, o);
    return v;
}
DI void h8_to_f(const half8 h, float (&f)[8]) {
#pragma unroll
    for (int i = 0; i < 8; ++i) f[i] = (float)h[i];
}
DI half8 f_to_h8(const float (&f)[8]) { half8 h;
#pragma unroll
    for (int i = 0; i < 8; ++i) h[i] = (h16)f[i];
    return h; }

#define XB_TMO      128
#define XB_XCNT(j)  (256  + 64 * (j))
#define XB_XSUB(j)  (1280 + 64 * (j))
#define XB_XGEN(j)  (2304 + 64 * (j))
#define XB_TOP      3328
#define XB_TOPGEN   3392
#define XCD_BAR_WORDS 3456
#define XB_SPIN_CAP (1u << 20)
__device__ __forceinline__ unsigned xb_ld(unsigned* p)              { return __hip_atomic_load(p, __ATOMIC_RELAXED, __HIP_MEMORY_SCOPE_AGENT); }
__device__ __forceinline__ unsigned xb_add(unsigned* p, unsigned v) { return __hip_atomic_fetch_add(p, v, __ATOMIC_RELAXED, __HIP_MEMORY_SCOPE_AGENT); }
__device__ __forceinline__ unsigned xb_xcc_id() { return (unsigned)__builtin_amdgcn_s_getreg((3 << 11) | 20) & 0xFu; }
#define XB_SPIN(cond, bar) do { unsigned _sp = 0; while (cond) { __builtin_amdgcn_s_sleep(1); \
    if ((++_sp & 255u) == 0u) { if (xb_ld(&(bar)[XB_TMO])) break; if (_sp > XB_SPIN_CAP) { atomicAdd(&(bar)[XB_TMO], 1u); break; } } } } while (0)
struct XcdBarrier { unsigned* bar; unsigned x; volatile LAS unsigned* st; int wave; };
__device__ __forceinline__ XcdBarrier xcd_barrier_post(unsigned* bar, volatile LAS unsigned* st, int wave) {
    XcdBarrier b; b.bar = bar; b.x = xb_xcc_id(); b.st = st; b.wave = wave;
    if (wave == 0 && opq_lane() == 0) (void)xb_add(&bar[XB_XCNT(b.x)], 1u);
    return b;
}
__device__ __forceinline__ void xcd_barrier_complete(unsigned* bar, unsigned x, unsigned& nloc, unsigned& nx) {
    const unsigned G = gridDim.x * gridDim.y * gridDim.z;
    asm volatile("" : "+s"(x));
    unsigned sum, cnt, mine, sp = 0u;
    for (;;) {
        sum = 0u; cnt = 0u; mine = 0u;
#pragma unroll
        for (unsigned j = 0; j < 16; ++j) { const unsigned c = xb_ld(&bar[XB_XCNT(j)]); sum += c; cnt += (c > 0u) ? 1u : 0u; mine = (j == x) ? c : mine; }
        if (sum == G) break;
        __builtin_amdgcn_s_sleep(1);
        if ((++sp & 255u) == 0u) { if (xb_ld(&bar[XB_TMO])) break; if (sp > XB_SPIN_CAP) { atomicAdd(&bar[XB_TMO], 1u); break; } }
    }
    nloc = mine > 0u ? mine : 1u; nx = cnt > 0u ? cnt : 1u;
}
__device__ __forceinline__ void xcd_barrier(const XcdBarrier& b) {
    asm volatile("s_waitcnt vmcnt(0)" ::: "memory");
    __syncthreads();
    if (b.wave == 0 && opq_lane() == 0) {
        unsigned* bar = b.bar; asm volatile("" : "+s"(bar));
        __builtin_amdgcn_s_waitcnt(0);
        unsigned nloc = b.st[0], nx = b.st[1];
        if (nloc == 0u) { xcd_barrier_complete(bar, b.x, nloc, nx); b.st[0] = nloc; b.st[1] = nx; }
        const unsigned old = xb_add(&bar[XB_XSUB(b.x)], 1u);
        const unsigned gen = old / nloc;
        if (old + 1u == (gen + 1u) * nloc) {
            __builtin_amdgcn_fence(__ATOMIC_RELEASE, "agent");
            asm volatile("s_waitcnt vmcnt(0)" ::: "memory");
            const unsigned og = xb_add(&bar[XB_TOP], 1u);
            const unsigned tg = og / nx;
            if (og + 1u == (tg + 1u) * nx) xb_add(&bar[XB_TOPGEN], 1u);
            else XB_SPIN(xb_ld(&bar[XB_TOPGEN]) == tg, bar);
            __builtin_amdgcn_fence(__ATOMIC_ACQUIRE, "agent");
            xb_add(&bar[XB_XGEN(b.x)], 1u);
            asm volatile("s_waitcnt vmcnt(0)" ::: "memory");
        } else {
            XB_SPIN(xb_ld(&bar[XB_XGEN(b.x)]) == gen, bar);
            __builtin_amdgcn_fence(__ATOMIC_ACQUIRE, "agent");
            asm volatile("s_waitcnt vmcnt(0)" ::: "memory");
        }
    }
    __syncthreads();
}

namespace pg8 {
constexpr int BM = 256, BK = 64, HALF = 128, HTB = HALF * BK * 2, STAGE_BYTES = 8 * HTB, NXCD = 8, WGM = 8;
__host__ __device__ __forceinline__ int lds_byte(int r, int c) { const int st = (r >> 4) * 2 + (c >> 5), rr = r & 15, cc = c & 31, ob = rr * 64 + cc * 2; return st * 1024 + (ob ^ (((ob >> 9) & 1) << 5)); }
__host__ __device__ __forceinline__ void stage_rc(int b, int& R, int& C) { const int st = b / 1024, sb = b % 1024, swz = sb ^ (((sb >> 9) & 1) << 5); R = (st >> 1) * 16 + swz / 64; C = (st & 1) * 32 + (swz % 64) / 2; }
__host__ __device__ __forceinline__ int perm32(int rho) { const int n = rho >> 4, i = rho & 15; return 8 * (i >> 2) + 4 * n + (i & 3); }

struct Unit { int pm, pn, g; };
struct Gemm { const h16* A; const h16* Bt; int lda, ldb, K; long gsA, gsB; };

struct StaticOrder {
    int nM, nN, nwg, G, c;
    __device__ void init(int M_, int N_, int G_, int c_) { nM = M_ / BM; nN = N_ / BM; nwg = nM * nN; G = G_; c = c_; }
    __device__ bool next(int i, Unit& u) const {
        const long L = (long)i * G + c; if (L >= nwg) return false;
        int wgid = (int)L; { const int q = nwg / NXCD, r = nwg % NXCD, xcd = wgid % NXCD, off = wgid / NXCD; wgid = (xcd < r ? xcd * (q + 1) : r * (q + 1) + (xcd - r) * q) + off; }
        const int nig = WGM * nN, gid = wgid / nig, fm = gid * WGM, gsz = (nM - fm) < WGM ? (nM - fm) : WGM;
        u.pm = fm + ((wgid % nig) % gsz); u.pn = (wgid % nig) / gsz; u.g = 0; return true;
    }
};
struct GroupOrder {
    int nM, nN, per, total, G, c;
    __device__ void init(int nM_, int nN_, int ng, int G_, int c_) { nM = nM_; nN = nN_; per = nM_ * nN_; total = per * ng; G = G_; c = c_; }
    __device__ bool next(int i, Unit& u) const {
        const long L = (long)i * G + c; if (L >= total) return false;
        const int l = (int)L; u.g = l / per; const int r = l % per; u.pm = r % nM; u.pn = r / nM; return true;
    }
};

__device__ __forceinline__ void glds16_s(const char* gbase, unsigned voff, unsigned lds_dst) {
    unsigned keep;
    asm volatile("s_mov_b32 %0, m0\n\ts_mov_b32 m0, %2\n\ts_nop 0\n\tglobal_load_lds_dwordx4 %1, %3\n\ts_mov_b32 m0, %0" : "=&s"(keep) : "v"(voff), "s"(lds_dst), "s"(gbase) : "memory");
}
template <class Epi, class Sched, bool ALIGN_EPI>
__device__ __forceinline__ void gemm_phase(LAS unsigned char* lds, const Gemm g, const Sched& S, const Epi& E, const int wid_in) {
    int lane; asm volatile("v_mbcnt_lo_u32_b32 %0, -1, 0\n\tv_mbcnt_hi_u32_b32 %0, -1, %0" : "=v"(lane));
    int wid = wid_in; asm volatile("" : "+s"(wid));
    const int tid = wid * 64 + lane, wr = wid >> 2, wc = wid & 3, fr = lane & 15, fq = lane >> 4;
    const int K = g.K, nt = K / BK;
    unsigned voffA[2], voffB[2];
#pragma unroll
    for (int i = 0; i < 2; ++i) { int R, C; stage_rc(tid * 16 + i * 8192, R, C); const int Rb = Epi::PERM ? ((R & ~31) + perm32(R & 31)) : R;
        voffA[i] = (unsigned)(R * g.lda + C) * 2u; voffB[i] = (unsigned)(Rb * g.ldb + C) * 2u; }
    const size_t kstep = (size_t)(BK * 2);
    const size_t hstepA = (size_t)HALF * g.lda * 2, hstepB = (size_t)HALF * g.ldb * 2;
    const size_t tstepA = 2 * hstepA, tstepB = 2 * hstepB;
    const unsigned ldsw = (unsigned)wid * 1024u, lds_u = (unsigned)(size_t)lds;
    const int aoff = lds_byte(wr * 64 + fr, fq * 8), boff = lds_byte(wc * 32 + fr, fq * 8);
#define PG8_SA(b, h) (((b) * 2 + (h)) * HTB)
#define PG8_SB(b, h) ((4 + (b) * 2 + (h)) * HTB)
#define PG8_STAGE(bufoff, gbase, voff) do { _Pragma("unroll") for (int _i = 0; _i < 2; ++_i) glds16_s((const char*)(gbase), (voff)[_i], lds_u + (unsigned)((bufoff) + _i * 8192) + ldsw); } while (0)
#define PG8_LDA(dst, b, h) do { _Pragma("unroll") for (int m = 0; m < 4; ++m) _Pragma("unroll") for (int k = 0; k < 2; ++k) dst[m][k] = *(const LAS half8*)(lds + PG8_SA(b, h) + aoff + m * 2048 + k * 1024); } while (0)
#define PG8_LDB(dst, b, h) do { _Pragma("unroll") for (int n = 0; n < 2; ++n) _Pragma("unroll") for (int k = 0; k < 2; ++k) dst[n][k] = *(const LAS half8*)(lds + PG8_SB(b, h) + boff + n * 2048 + k * 1024); } while (0)
#define PG8_MMA(ai, bj, At, Bt) do { __builtin_amdgcn_s_setprio(1); _Pragma("unroll") for (int m = 0; m < 4; ++m) _Pragma("unroll") for (int n = 0; n < 2; ++n) _Pragma("unroll") for (int k = 0; k < 2; ++k) \
        acc[ai][bj][m][n] = __builtin_amdgcn_mfma_f32_16x16x32_f16(Bt[n][k], At[m][k], acc[ai][bj][m][n], 0, 0, 0); __builtin_amdgcn_s_setprio(0); } while (0)
#define PG8_WAIT_V(n) asm volatile("s_waitcnt vmcnt(" #n ")" ::: "memory")
#define PG8_WAIT_L(n) asm volatile("s_waitcnt lgkmcnt(" #n ")" ::: "memory")
#define PG8_BAR __builtin_amdgcn_s_barrier()
#define PG8_SCHED __builtin_amdgcn_sched_barrier(0)
    Unit cur, nxt; int ui = 0;
    if (!S.next(0, cur)) return;
    f32x4 acc[2][2][4][2];
#pragma unroll
    for (int a = 0; a < 2; ++a)
#pragma unroll
        for (int b = 0; b < 2; ++b)
#pragma unroll
            for (int m = 0; m < 4; ++m)
#pragma unroll
                for (int n = 0; n < 2; ++n) acc[a][b][m][n] = (f32x4){0.f, 0.f, 0.f, 0.f};
    half8 At[4][2], B0[2][2], B1[2][2];
    const char* cA = (const char*)g.A + (size_t)cur.g * g.gsA * 2 + (size_t)cur.pm * tstepA;
    const char* cB = (const char*)g.Bt + (size_t)cur.g * g.gsB * 2 + (size_t)cur.pn * tstepB;
    PG8_STAGE(PG8_SB(0, 0), cB, voffB); PG8_STAGE(PG8_SB(0, 1), cB + hstepB, voffB); PG8_STAGE(PG8_SA(0, 0), cA, voffA); PG8_STAGE(PG8_SA(0, 1), cA + hstepA, voffA);
    if (wr == 1) PG8_BAR;
    PG8_WAIT_V(2); PG8_BAR;
    PG8_STAGE(PG8_SB(1, 0), cB + kstep, voffB); PG8_STAGE(PG8_SA(1, 0), cA + kstep, voffA); PG8_STAGE(PG8_SB(1, 1), cB + hstepB + kstep, voffB);
    PG8_WAIT_V(6); PG8_BAR;
    for (;;) {
        const bool has_next = S.next(ui + 1, nxt);
        const char* nA = has_next ? (const char*)g.A + (size_t)nxt.g * g.gsA * 2 + (size_t)nxt.pm * tstepA : cA;
        const char* nB = has_next ? (const char*)g.Bt + (size_t)nxt.g * g.gsB * 2 + (size_t)nxt.pn * tstepB : cB;
        for (int t = 0; t < nt; t += 2) {
            const bool last = (t == nt - 2);
            const char* a1 = cA + (size_t)(t + 1) * kstep;
            const char* a2 = last ? nA : cA + (size_t)(t + 2) * kstep; const char* b2 = last ? nB : cB + (size_t)(t + 2) * kstep;
            const char* a3 = a2 + kstep; const char* b3 = b2 + kstep;
            PG8_LDB(B0, 0, 0); PG8_LDB(B1, 0, 1); PG8_SCHED; PG8_LDA(At, 0, 0); PG8_STAGE(PG8_SA(1, 1), a1 + hstepA, voffA);
            PG8_WAIT_V(8); PG8_WAIT_L(0); PG8_BAR; PG8_MMA(0, 0, At, B0); PG8_MMA(0, 1, At, B1); PG8_BAR; PG8_SCHED;
            PG8_LDA(At, 0, 1); PG8_STAGE(PG8_SB(0, 0), b2, voffB); PG8_STAGE(PG8_SB(0, 1), b2 + hstepB, voffB); PG8_STAGE(PG8_SA(0, 0), a2, voffA);
            PG8_WAIT_V(8); PG8_WAIT_L(0); PG8_BAR; PG8_MMA(1, 0, At, B0); PG8_MMA(1, 1, At, B1); PG8_BAR; PG8_SCHED;
            PG8_LDB(B0, 1, 0); PG8_LDB(B1, 1, 1); PG8_SCHED; PG8_LDA(At, 1, 0); PG8_STAGE(PG8_SA(0, 1), a2 + hstepA, voffA);
            PG8_WAIT_V(8); PG8_WAIT_L(0); PG8_BAR; PG8_MMA(0, 0, At, B0); PG8_MMA(0, 1, At, B1); PG8_BAR; PG8_SCHED;
            PG8_LDA(At, 1, 1); PG8_STAGE(PG8_SB(1, 0), b3, voffB); PG8_STAGE(PG8_SB(1, 1), b3 + hstepB, voffB); PG8_STAGE(PG8_SA(1, 0), a3, voffA);
            PG8_WAIT_V(8); PG8_WAIT_L(0); PG8_BAR; PG8_MMA(1, 0, At, B0); PG8_MMA(1, 1, At, B1); PG8_BAR; PG8_SCHED;
        }
        if constexpr (ALIGN_EPI) { if (wr == 0) PG8_BAR; }
        { int ln2; asm volatile("v_mbcnt_lo_u32_b32 %0, -1, 0\n\tv_mbcnt_hi_u32_b32 %0, -1, %0" : "=v"(ln2)); E(acc, cur, wr, wc, ln2 & 15, ln2 >> 4); }
        if (!has_next) break;
#pragma unroll
        for (int a = 0; a < 2; ++a)
#pragma unroll
            for (int b = 0; b < 2; ++b)
#pragma unroll
                for (int m = 0; m < 4; ++m)
#pragma unroll
                    for (int n = 0; n < 2; ++n) acc[a][b][m][n] = (f32x4){0.f, 0.f, 0.f, 0.f};
        cur = nxt; cA = nA; cB = nB; ++ui;
        if constexpr (ALIGN_EPI) { if (wr == 1) PG8_BAR; }
    }
    PG8_WAIT_V(0);
    if constexpr (!ALIGN_EPI) { if (wr == 0) PG8_BAR; }
    PG8_BAR;
#undef PG8_SA
#undef PG8_SB
#undef PG8_STAGE
#undef PG8_LDA
#undef PG8_LDB
#undef PG8_MMA
#undef PG8_WAIT_V
#undef PG8_WAIT_L
#undef PG8_BAR
#undef PG8_SCHED
}

typedef f32x4 Acc[2][2][4][2];

struct EpiProj {
    static constexpr bool PERM = true;
    h16* P; h16* UG;
    DI void operator()(const Acc& acc, const Unit& u, int wr, int wc, int fr, int fq) const {
        const int row0 = u.pm * BM + wr * 64 + fr, col0 = u.pn * BM + wc * 32 + 8 * fq;
        const bool s5 = (u.pn == 8 || u.pn == 9);
#pragma unroll
        for (int ai = 0; ai < 2; ++ai)
#pragma unroll
            for (int m = 0; m < 4; ++m) { const int row = row0 + ai * HALF + m * 16;
#pragma unroll
                for (int bj = 0; bj < 2; ++bj) { const f32x4 v0 = acc[ai][bj][m][0], v1 = acc[ai][bj][m][1]; const int c = col0 + bj * HALF;
                    u32x4 w; w.x = pkh(v0[0], v0[1]); w.y = pkh(v0[2], v0[3]); w.z = pkh(v1[0], v1[1]); w.w = pkh(v1[2], v1[3]);
                    *(u32x4*)(P + (size_t)row * NIN + c) = w;
                    if (s5) { const int cc = c - 2048, gg = cc >> 4, ch = cc & 15, bc = row >> 5, t = row & 31;
                        *(u32x4*)(UG + ((size_t)gg * S5NC + bc) * S5K3 + t * 16 + ch) = w; } }
                asm volatile("" ::: "memory"); }
    }
};
struct EpiRes {
    static constexpr bool PERM = false;
    const float* xin; float* xout; const float* gate;
    DI void operator()(const Acc& acc, const Unit& u, int wr, int wc, int fr, int fq) const {
        const int row0 = u.pm * BM + wr * 64 + fr, col0 = u.pn * BM + wc * 32 + 4 * fq, b = u.pm >> 4;
        f32x4 gv[2][2];
#pragma unroll
        for (int bj = 0; bj < 2; ++bj)
#pragma unroll
            for (int n = 0; n < 2; ++n) gv[bj][n] = *(const f32x4*)(gate + (size_t)b * MODW + col0 + bj * HALF + n * 16);
#pragma unroll
        for (int ai = 0; ai < 2; ++ai)
#pragma unroll
            for (int m = 0; m < 4; ++m) { const size_t off = (size_t)(row0 + ai * HALF + m * 16) * DM + col0;
#pragma unroll
                for (int bj = 0; bj < 2; ++bj)
#pragma unroll
                    for (int n = 0; n < 2; ++n) { const f32x4 xv = *(const f32x4*)(xin + off + bj * HALF + n * 16);
                        *(f32x4*)(xout + off + bj * HALF + n * 16) = DN_ALPHA * xv + gv[bj][n] * acc[ai][bj][m][n]; }
                asm volatile("" ::: "memory"); }
    }
};
struct EpiSwiGLU {
    static constexpr bool PERM = true;
    h16* O;
    DI void operator()(const Acc& acc, const Unit& u, int wr, int wc, int fr, int fq) const {
        const int row0 = u.pm * BM + wr * 64 + fr, col0 = u.pn * HALF + wc * 32 + 8 * fq;
#pragma unroll
        for (int ai = 0; ai < 2; ++ai)
#pragma unroll
            for (int m = 0; m < 4; ++m) { float o[8];
#pragma unroll
                for (int n = 0; n < 2; ++n)
#pragma unroll
                    for (int j = 0; j < 4; ++j) o[4 * n + j] = siluf_(acc[ai][0][m][n][j]) * acc[ai][1][m][n][j];
                u32x4 w; w.x = pkh(o[0], o[1]); w.y = pkh(o[2], o[3]); w.z = pkh(o[4], o[5]); w.w = pkh(o[6], o[7]);
                *(u32x4*)(O + (size_t)(row0 + ai * HALF + m * 16) * DFF + col0) = w; asm volatile("" ::: "memory"); }
    }
};
struct EpiLR {
    static constexpr bool PERM = true;
    h16* O;
    DI void operator()(const Acc& acc, const Unit& u, int wr, int wc, int fr, int fq) const {
        const int row0 = u.pm * BM + wr * 64 + fr, col0 = u.pn * BM + wc * 32 + 8 * fq;
#pragma unroll
        for (int ai = 0; ai < 2; ++ai)
#pragma unroll
            for (int m = 0; m < 4; ++m) { const int row = row0 + ai * HALF + m * 16;
#pragma unroll
                for (int bj = 0; bj < 2; ++bj) { const f32x4 v0 = acc[ai][bj][m][0], v1 = acc[ai][bj][m][1];
                    u32x4 w; w.x = pkh(v0[0], v0[1]); w.y = pkh(v0[2], v0[3]); w.z = pkh(v1[0], v1[1]); w.w = pkh(v1[2], v1[3]);
                    *(u32x4*)(O + (size_t)row * 1536 + col0 + bj * HALF) = w; }
                asm volatile("" ::: "memory"); }
    }
};
struct EpiS5h {
    static constexpr bool PERM = false;
    float* H;
    DI void operator()(const Acc& acc, const Unit& u, int wr, int wc, int fr, int fq) const {
        const int row0 = u.pm * BM + wr * 64 + fr, col0 = wc * 32 + 4 * fq;
#pragma unroll
        for (int ai = 0; ai < 2; ++ai)
#pragma unroll
            for (int m = 0; m < 4; ++m)
#pragma unroll
                for (int n = 0; n < 2; ++n) *(f32x4*)(H + ((size_t)u.g * S5NC + row0 + ai * HALF + m * 16) * 128 + col0 + n * 16) = acc[ai][0][m][n];
    }
};
struct EpiS5y {
    static constexpr bool PERM = true;
    const h16* P; const float* dskip; h16* Y;
    DI void operator()(const Acc& acc, const Unit& u, int wr, int wc, int fr, int fq) const {
        const int row0 = u.pm * BM + wr * 64 + fr, col0 = u.pn * BM + wc * 32 + 8 * fq;
#pragma unroll
        for (int bj = 0; bj < 2; ++bj) { const int c = col0 + bj * HALF, t = c >> 4, ch = c & 15, chan = u.g * 16 + ch;
            float d[8];
#pragma unroll
            for (int j = 0; j < 8; ++j) d[j] = dskip[chan + j];
#pragma unroll
            for (int ai = 0; ai < 2; ++ai)
#pragma unroll
                for (int m = 0; m < 4; ++m) { const int bc = row0 + ai * HALF + m * 16; const size_t tok = (size_t)bc * S5L + t;
                    const half8 uv = *(const half8*)(P + tok * NIN + 2048 + chan); float o[8];
#pragma unroll
                    for (int n = 0; n < 2; ++n)
#pragma unroll
                        for (int j = 0; j < 4; ++j) o[4 * n + j] = gelu_tanhf_(acc[ai][bj][m][n][j] + d[4 * n + j] * (float)uv[4 * n + j]);
                    u32x4 w; w.x = pkh(o[0], o[1]); w.y = pkh(o[2], o[3]); w.z = pkh(o[4], o[5]); w.w = pkh(o[6], o[7]);
                    *(u32x4*)(Y + tok * DG + chan) = w; asm volatile("" ::: "memory"); } }
    }
};
struct EpiGLU {
    static constexpr bool PERM = true;
    const h16* Y; const float* gb; h16* MIX;
    DI void operator()(const Acc& acc, const Unit& u, int wr, int wc, int fr, int fq) const {
        const int row0 = u.pm * BM + wr * 64 + fr, col0 = u.pn * BM + wc * 32 + 8 * fq;
#pragma unroll
        for (int bj = 0; bj < 2; ++bj) { const int c = col0 + bj * HALF; float bias[8];
#pragma unroll
            for (int j = 0; j < 8; ++j) bias[j] = gb[c + j];
#pragma unroll
            for (int ai = 0; ai < 2; ++ai)
#pragma unroll
                for (int m = 0; m < 4; ++m) { const size_t row = (size_t)(row0 + ai * HALF + m * 16);
                    const half8 yv = *(const half8*)(Y + row * DG + c); float o[8];
#pragma unroll
                    for (int n = 0; n < 2; ++n)
#pragma unroll
                        for (int j = 0; j < 4; ++j) o[4 * n + j] = (float)yv[4 * n + j] * sigmoidf_(acc[ai][bj][m][n][j] + bias[4 * n + j]);
                    u32x4 w; w.x = pkh(o[0], o[1]); w.y = pkh(o[2], o[3]); w.z = pkh(o[4], o[5]); w.w = pkh(o[6], o[7]);
                    *(u32x4*)(MIX + row * DM + 512 + c) = w; asm volatile("" ::: "memory"); } }
    }
};
}

struct Args { const float* in[36]; float* out; unsigned char* ws; int ph_lo, ph_hi; };
enum { I_X = 0, I_C, I_ADAW, I_ADAB, I_WIN, I_WOUT, I_HGLB, I_HGNG, I_S5ARE, I_S5AIM, I_S5LDT, I_S5BRE, I_S5BIM, I_S5CRE, I_S5CIM, I_S5D, I_GLUW, I_GLUB,
       I_RWMU, I_RWW0, I_RWW2, I_RWA0, I_RWA2, I_RWG2, I_RWKK, I_RWKA, I_RWRK, I_RWGNG, I_RWGNB, I_LN1G, I_LN1B, I_FW1, I_FW3, I_FW2, I_LN2G, I_LN2B };

struct Frame {
    LAS unsigned char* lds;
    unsigned char* ws; float* out; int wave;
};
DI int opq_bid() { int b = blockIdx.x; asm volatile("" : "+s"(b)); return b; }
DI float opq_f(float c) { asm volatile("" : "+s"(c)); return c; }
#define PHASE_IDS const int lane = opq_lane(), wave = F.wave, tid = wave * 64 + lane, G = gridDim.x, bid = opq_bid(), gw = bid * NWAVES + wave, NGW = G * NWAVES; (void)lane; (void)gw; (void)NGW; (void)G; (void)bid; (void)tid;
template <class T> DI T* wsp(const Frame& F, size_t off) { unsigned o = (unsigned)off; asm volatile("" : "+s"(o)); return (T*)(F.ws + o); }
DI const float* inp(const Frame& F, int i) { (void)F; int k = i; asm volatile("" : "+s"(k));
    const __attribute__((address_space(4))) unsigned long long* t = (const __attribute__((address_space(4))) unsigned long long*)__builtin_amdgcn_kernarg_segment_ptr(); return (const float*)t[k]; }
template <class RowMap>
DI void transpose_item(const float* W, int N, h16* WT, int ldd, const RowMap& rm, LAS float* scr, int item, int lane) {
    const int nblk = N / 32, kb = item / nblk, nb = item % nblk, k0 = 64 * kb, n0 = 32 * nb;
#pragma unroll 8
    for (int i = 0; i < 32; ++i) { const int kk = 2 * i + (lane >> 5); scr[kk * 33 + (lane & 31)] = W[(size_t)(k0 + kk) * N + n0 + (lane & 31)]; }
    asm volatile("s_waitcnt lgkmcnt(0)" ::: "memory");
    const int c = lane & 7;
#pragma unroll
    for (int j = 0; j < 4; ++j) { const int n = (lane >> 3) + 8 * j; const LAS float* s = scr + (8 * c) * 33 + n;
        u32x4 o; o.x = pkh(s[0 * 33], s[1 * 33]); o.y = pkh(s[2 * 33], s[3 * 33]); o.z = pkh(s[4 * 33], s[5 * 33]); o.w = pkh(s[6 * 33], s[7 * 33]);
        *(u32x4*)(WT + (size_t)rm(n0 + n) * ldd + k0 + 8 * c) = o; }
    asm volatile("s_waitcnt lgkmcnt(0)" ::: "memory");
}
struct RmId { DI int operator()(int n) const { return n; } };
struct RmW13 { int add; DI int operator()(int n) const { return 256 * (n >> 7) + (n & 127) + add; } };

DI void cis_turns(double turns, float& c, float& s) { const double fr = turns - __builtin_rint(turns); const float f = (float)fr; c = __builtin_amdgcn_cosf(f); s = __builtin_amdgcn_sinf(f); }
struct S5Par { float ar, ai, dt; };
DI void s5_lampow(const S5Par& p, int tau, float& lr, float& li) {
    const float mag = __expf(p.ar * p.dt * (float)tau);
    float c, s; cis_turns((double)p.ai * (double)p.dt * (double)tau * 0.15915494309189535, c, s);
    lr = mag * c; li = mag * s;
}
DI void s5_z(const S5Par& p, float& zr, float& zi) {
    float lr, li; s5_lampow(p, 1, lr, li);
    const float rden = __builtin_amdgcn_rcpf(p.ar * p.ar + p.ai * p.ai);
    zr = ((lr - 1.f) * p.ar + li * p.ai) * rden; zi = (li * p.ar - (lr - 1.f) * p.ai) * rden;
}

DI void convert_weights(const Frame& F, int l) { PHASE_IDS
    LAS float* scr = (LAS float*)(F.lds + wave * 16384);
    h16* WIN = wsp<h16>(F, WS_WIN); h16* WOUT = wsp<h16>(F, WS_WOUT); h16* W13 = wsp<h16>(F, WS_W13); h16* W2 = wsp<h16>(F, WS_W2); h16* GLU = wsp<h16>(F, WS_GLU);
    constexpr int I_A = (DM / 64) * (NIN / 32), I_B = (DM / 64) * (DM / 32), I_C1 = (DM / 64) * (DFF / 32), I_D = (DFF / 64) * (DM / 32), I_E = (DG / 64) * (DG / 32);
    constexpr int NIT = I_A + I_B + 2 * I_C1 + I_D + I_E;
    for (int it = gw; it < NIT; it += NGW) {
        int r = it;
        if (r < I_A) { transpose_item(inp(F, I_WIN) + (size_t)l * DM * NIN, NIN, WIN, DM, RmId{}, scr, r, lane); continue; } r -= I_A;
        if (r < I_B) { transpose_item(inp(F, I_WOUT) + (size_t)l * DM * DM, DM, WOUT, DM, RmId{}, scr, r, lane); continue; } r -= I_B;
        if (r < I_C1) { transpose_item(inp(F, I_FW1) + (size_t)l * DM * DFF, DFF, W13, DM, RmW13{0}, scr, r, lane); continue; } r -= I_C1;
        if (r < I_C1) { transpose_item(inp(F, I_FW3) + (size_t)l * DM * DFF, DFF, W13, DM, RmW13{128}, scr, r, lane); continue; } r -= I_C1;
        if (r < I_D) { transpose_item(inp(F, I_FW2) + (size_t)l * DFF * DM, DM, W2, DFF, RmId{}, scr, r, lane); continue; } r -= I_D;
        transpose_item(inp(F, I_GLUW) + (size_t)l * DG * DG, DG, GLU, DG, RmId{}, scr, r, lane);
    }
    const size_t gt = (size_t)bid * 512 + tid, GT = (size_t)G * 512;
    { h16* LRT = wsp<h16>(F, WS_LRT); const float* w2 = inp(F, I_RWW2) + (size_t)l * 64 * DG; const float* a2 = inp(F, I_RWA2) + (size_t)l * 64 * DG; const float* g2 = inp(F, I_RWG2) + (size_t)l * 128 * DG;
        for (size_t i = gt; i < (size_t)1536 * 256; i += GT) { const int n = (int)(i >> 8), k = (int)(i & 255); float v = 0.f;
            if (n < 512) { if (k < 64) v = w2[k * DG + n]; }
            else if (n < 1024) { if (k >= 64 && k < 128) v = a2[(k - 64) * DG + (n - 512)]; }
            else { if (k >= 128) v = g2[(k - 128) * DG + (n - 1024)]; }
            LRT[i] = (h16)v; } }
    const float* are = inp(F, I_S5ARE) + l * 2048; const float* aim = inp(F, I_S5AIM) + l * 2048; const float* ldt = inp(F, I_S5LDT) + l * 32;
    const float* bre = inp(F, I_S5BRE) + (size_t)l * 32768; const float* bim = inp(F, I_S5BIM) + (size_t)l * 32768;
    const float* cre = inp(F, I_S5CRE) + (size_t)l * 32768; const float* cim = inp(F, I_S5CIM) + (size_t)l * 32768;
    h16* T3 = wsp<h16>(F, WS_S5T3); h16* T1 = wsp<h16>(F, WS_S5T1);
    for (int un = bid; un < 32 * 63; un += G) { const int g = un / 63, delta = un % 63 - 31;
        if (tid < 256) { const int c = tid >> 4, cp = tid & 15; float kv = 0.f;
            if (delta >= 0) { const float dt = __expf(ldt[g]);
                for (int p = 0; p < 64; ++p) { S5Par sp{are[g * 64 + p], aim[g * 64 + p], dt}; float lr, li, zr, zi; s5_lampow(sp, delta, lr, li); s5_z(sp, zr, zi);
                    const float br = bre[(g * 64 + p) * 16 + cp], bi = bim[(g * 64 + p) * 16 + cp];
                    const float bbr = zr * br - zi * bi, bbi = zr * bi + zi * br;
                    const float mr = lr * bbr - li * bbi, mi = lr * bbi + li * bbr;
                    kv += cre[(g * 16 + c) * 64 + p] * mr - cim[(g * 16 + c) * 64 + p] * mi; } }
            const h16 hv = (h16)kv;
            for (int t = 0; t < 32; ++t) { const int s = t - delta; if (s >= 0 && s < 32) T3[((size_t)g * 512 + t * 16 + c) * S5K3 + s * 16 + cp] = hv; } }
    }
    for (size_t i = gt; i < (size_t)32 * 512 * 128; i += GT) { const int n = (int)(i & 127), tc = (int)((i >> 7) & 511), g = (int)(i >> 16); const int t = tc >> 4, c = tc & 15, p = n & 63;
        S5Par sp{are[g * 64 + p], aim[g * 64 + p], __expf(ldt[g])}; float lr, li; s5_lampow(sp, t + 1, lr, li);
        const float cr = cre[(g * 16 + c) * 64 + p], ci = cim[(g * 16 + c) * 64 + p];
        const float v = n < 64 ? (cr * lr - ci * li) : -(cr * li + ci * lr);
        T3[((size_t)g * 512 + tc) * S5K3 + 512 + n] = (h16)v; }
    for (size_t i = gt; i < (size_t)32 * 256 * 512; i += GT) { const int sc = (int)(i & 511), n = (int)((i >> 9) & 255), g = (int)(i >> 17); float v = 0.f;
        if (n < 128) { const int p = n & 63, s = sc >> 4, c = sc & 15; S5Par sp{are[g * 64 + p], aim[g * 64 + p], __expf(ldt[g])}; float lr, li, zr, zi; s5_lampow(sp, 31 - s, lr, li); s5_z(sp, zr, zi);
            const float br = bre[(g * 64 + p) * 16 + c], bi = bim[(g * 64 + p) * 16 + c]; const float bbr = zr * br - zi * bi, bbi = zr * bi + zi * br;
            v = n < 64 ? (lr * bbr - li * bbi) : (lr * bbi + li * bbr); }
        T1[i] = (h16)v; }
}

DI void p0_mod(const Frame& F) { PHASE_IDS
    LAS float* cact = (LAS float*)F.lds;
    LAS float* red = (LAS float*)(F.lds + 65536);
    for (int i = tid; i < BATCH * DM; i += 512) cact[i] = siluf_(inp(F, I_C)[i]);
    __syncthreads();
    float* MOD = wsp<float>(F, WS_MOD);
    const int ks = tid >> 6, col = tid & 63;
    for (int un = bid; un < DEPTH * (MODW / 64); un += G) { const int l = un / (MODW / 64), cb = un % (MODW / 64);
        const float* w = inp(F, I_ADAW) + (size_t)l * DM * MODW + cb * 64 + col; float a[8] = {0, 0, 0, 0, 0, 0, 0, 0};
        for (int k = ks * 256; k < ks * 256 + 256; ++k) { const float wv = w[(size_t)k * MODW];
#pragma unroll
            for (int b = 0; b < 8; ++b) a[b] += cact[b * DM + k] * wv; }
#pragma unroll
        for (int b = 0; b < 8; ++b) red[(ks * 8 + b) * 64 + col] = a[b];
        __syncthreads();
        { const int b = tid >> 6; float s = 0.f;
#pragma unroll
            for (int k2 = 0; k2 < 8; ++k2) s += red[(k2 * 8 + b) * 64 + col];
            MOD[((size_t)l * BATCH + b) * MODW + cb * 64 + col] = s + inp(F, I_ADAB)[l * MODW + cb * 64 + col]; }
        __syncthreads();
    }
    if (bid == 0) { float* LB = wsp<float>(F, WS_LB); const int c = tid; const float* lg = inp(F, I_HGLB);
        const float v0 = lg[c], v1 = lg[512 + c], v2 = lg[1024 + c], v3 = lg[1536 + c]; const float mx = fmaxf(fmaxf(v0, v1), fmaxf(v2, v3));
        const float e0 = __expf(v0 - mx), e1 = __expf(v1 - mx), e2 = __expf(v2 - mx), e3 = __expf(v3 - mx), inv = __builtin_amdgcn_rcpf(e0 + e1 + e2 + e3);
        LB[c] = 0.f; LB[512 + c] = e1 * inv; LB[1024 + c] = (e1 + e2) * inv; LB[1536 + c] = (e1 + e2 + e3) * inv; }
    __syncthreads();
}
DI void modulate_rows(const Frame& F, const float* x, const float* modl, int shift_idx, h16* H) { PHASE_IDS
    for (int row = gw; row < M; row += NGW) { const int b = row >> 12; const float* sh = modl + (size_t)b * MODW + shift_idx * DM; const float* sc = sh + DM;
#pragma unroll
        for (int j = 0; j < 4; ++j) { const int c = j * 512 + lane * 8; const f32x4 x0 = *(const f32x4*)(x + (size_t)row * DM + c), x1 = *(const f32x4*)(x + (size_t)row * DM + c + 4);
            const f32x4 s0 = *(const f32x4*)(sc + c), s1 = *(const f32x4*)(sc + c + 4), h0 = *(const f32x4*)(sh + c), h1 = *(const f32x4*)(sh + c + 4);
            const f32x4 y0 = x0 * (1.f + s0) + h0, y1 = x1 * (1.f + s1) + h1;
            u32x4 w; w.x = pkh(y0[0], y0[1]); w.y = pkh(y0[2], y0[3]); w.z = pkh(y1[0], y1[1]); w.w = pkh(y1[2], y1[3]);
            *(u32x4*)(H + (size_t)row * DM + c) = w; } }
}
DI void ln_rows(const Frame& F, const float* xi, float* xo, const float* g, const float* bta, const float* modn, int shift_idx, h16* H) { PHASE_IDS
    for (int row = gw; row < M; row += NGW) { const int b = row >> 12;
        f32x4 v[8]; float s = 0.f;
#pragma unroll
        for (int j = 0; j < 8; ++j) { v[j] = *(const f32x4*)(xi + (size_t)row * DM + j * 256 + lane * 4); s += (v[j][0] + v[j][1]) + (v[j][2] + v[j][3]); }
        const float mean = wave_sum(s) * (1.f / DM); float q = 0.f;
#pragma unroll
        for (int j = 0; j < 8; ++j) { v[j] = v[j] - mean; q += (v[j][0] * v[j][0] + v[j][1] * v[j][1]) + (v[j][2] * v[j][2] + v[j][3] * v[j][3]); }
        const float rstd = rsqrtf_(wave_sum(q) * (1.f / DM) + opq_f(LN_EPS));
#pragma unroll
        for (int j = 0; j < 8; ++j) { const int c = j * 256 + lane * 4; const f32x4 y = v[j] * rstd * *(const f32x4*)(g + c) + *(const f32x4*)(bta + c);
            *(f32x4*)(xo + (size_t)row * DM + c) = y;
            if (H) { const float* sh = modn + (size_t)b * MODW + shift_idx * DM; const f32x4 hh = y * (1.f + *(const f32x4*)(sh + DM + c)) + *(const f32x4*)(sh + c);
                u32x2 w; w.x = pkh(hh[0], hh[1]); w.y = pkh(hh[2], hh[3]); *(u32x2*)(H + (size_t)row * DM + c) = w; } }
    }
}

DI void prep_rows(const Frame& F, int l) { PHASE_IDS
    const h16* P = wsp<h16>(F, WS_PROJ); h16* RWA = wsp<h16>(F, WS_RWA); h16* HGK = wsp<h16>(F, WS_HGK); h16* HGQ = wsp<h16>(F, WS_HGQ);
    const float* mu = inp(F, I_RWMU) + l * 1792; const float* LB = wsp<float>(F, WS_LB) + l * 512;
    float mu4[4], lb8[8];
#pragma unroll
    for (int j = 0; j < 4; ++j) mu4[j] = mu[1536 + 4 * lane + j];
#pragma unroll
    for (int j = 0; j < 8; ++j) lb8[j] = 1.f - LB[8 * lane + j];
    for (int row = gw; row < M; row += NGW) { const int t = row & (SEQ - 1); const h16* pr = P + (size_t)row * NIN;
        { const half4 cur = *(const half4*)(pr + RWOFF + 1536 + 4 * lane); half4 prv = {0, 0, 0, 0}; if (t > 0) prv = *(const half4*)(pr - NIN + RWOFF + 1536 + 4 * lane);
            float o[4];
#pragma unroll
            for (int j = 0; j < 4; ++j) { const float cv = (float)cur[j], sv = cv + mu4[j] * ((float)prv[j] - cv); o[j] = lane < 16 ? tanhf_(sv) : (lane < 32 ? sv : sigmoidf_(sv)); }
            u32x2 w; w.x = pkh(o[0], o[1]); w.y = pkh(o[2], o[3]); *(u32x2*)(RWA + (size_t)row * 256 + 4 * lane) = w; }
        { const half8 qv = *(const half8*)(pr + 8 * lane), zv = *(const half8*)(pr + 512 + 8 * lane); float k[8], q[8];
#pragma unroll
            for (int j = 0; j < 8; ++j) { k[j] = lb8[j] * sigmoidf_(-(float)zv[j]); q[j] = siluf_((float)qv[j]); }
            *(half8*)(HGK + (size_t)row * DG + 8 * lane) = f_to_h8(k); *(half8*)(HGQ + (size_t)row * DG + 8 * lane) = f_to_h8(q); }
    }
}
DI void rwkv_prep_rows(const Frame& F, int l) { PHASE_IDS
    const h16* P = wsp<h16>(F, WS_PROJ); const h16* LR = wsp<h16>(F, WS_LR16); h16* A16 = wsp<h16>(F, WS_RWA16); float* WW = wsp<float>(F, WS_RWW);
    h16* KK = wsp<h16>(F, WS_RWKK); h16* KP = wsp<h16>(F, WS_RWKP); h16* R = wsp<h16>(F, WS_RWR); h16* V = wsp<h16>(F, WS_RWV);
    const float* mu = inp(F, I_RWMU) + l * 1792; const int c0 = 8 * lane;
    float mur[8], muk[8], muv[8], kk_[8], ka_[8], w0_[8], a0_[8];
#pragma unroll
    for (int j = 0; j < 8; ++j) { w0_[j] = inp(F, I_RWW0)[l * DG + c0 + j]; a0_[j] = inp(F, I_RWA0)[l * DG + c0 + j]; mur[j] = mu[c0 + j]; muk[j] = mu[512 + c0 + j]; muv[j] = mu[1024 + c0 + j]; kk_[j] = inp(F, I_RWKK)[l * DG + c0 + j]; ka_[j] = inp(F, I_RWKA)[l * DG + c0 + j]; }
    for (int row = gw; row < M; row += NGW) { const int t = row & (SEQ - 1); const h16* pr = P + (size_t)row * NIN + RWOFF;
        half8 rc = *(const half8*)(pr + c0), kc = *(const half8*)(pr + 512 + c0), vc = *(const half8*)(pr + 1024 + c0), rp, kp, vp;
        if (t > 0) { rp = *(const half8*)(pr - NIN + c0); kp = *(const half8*)(pr - NIN + 512 + c0); vp = *(const half8*)(pr - NIN + 1024 + c0); }
        else {
#pragma unroll
            for (int j = 0; j < 8; ++j) { rp[j] = 0; kp[j] = 0; vp[j] = 0; } }
        const half8 zw = *(const half8*)(LR + (size_t)row * 1536 + c0), za = *(const half8*)(LR + (size_t)row * 1536 + 512 + c0);
        float av[8], wd[8];
#pragma unroll
        for (int j = 0; j < 8; ++j) { av[j] = sigmoidf_((float)za[j] + a0_[j]); wd[j] = __expf(-0.6065306597126334f * sigmoidf_((float)zw[j] + w0_[j])); }
        *(f32x4*)(WW + (size_t)row * DG + c0) = (f32x4){wd[0], wd[1], wd[2], wd[3]}; *(f32x4*)(WW + (size_t)row * DG + c0 + 4) = (f32x4){wd[4], wd[5], wd[6], wd[7]};
        *(half8*)(A16 + (size_t)row * DG + c0) = f_to_h8(av);
        float r[8], k[8], v[8], kkr[8], kpo[8], n2 = 0.f;
#pragma unroll
        for (int j = 0; j < 8; ++j) { const float rcv = (float)rc[j], kcv = (float)kc[j], vcv = (float)vc[j];
            r[j] = rcv + mur[j] * ((float)rp[j] - rcv); k[j] = kcv + muk[j] * ((float)kp[j] - kcv); v[j] = vcv + muv[j] * ((float)vp[j] - vcv);
            kkr[j] = k[j] * kk_[j]; n2 += kkr[j] * kkr[j]; kpo[j] = k[j] * (1.f + (av[j] - 1.f) * ka_[j]); }
        n2 = sum8(n2);
        const float rn = rsqrtf_(fmaxf(n2, 1e-24f));
#pragma unroll
        for (int j = 0; j < 8; ++j) kkr[j] *= rn;
        *(half8*)(KK + (size_t)row * DG + c0) = f_to_h8(kkr); *(half8*)(KP + (size_t)row * DG + c0) = f_to_h8(kpo);
        *(half8*)(R + (size_t)row * DG + c0) = f_to_h8(r); *(half8*)(V + (size_t)row * DG + c0) = f_to_h8(v);
    }
}
DI void s5_chunk_scan(const Frame& F, int l) { PHASE_IDS
    const float* HL = wsp<float>(F, WS_HLOC); h16* UG = wsp<h16>(F, WS_UG);
    const float* are = inp(F, I_S5ARE) + l * 2048; const float* aim = inp(F, I_S5AIM) + l * 2048; const float* ldt = inp(F, I_S5LDT) + l * 32;
    for (int un = gw; un < 32 * BATCH; un += NGW) { const int g = un >> 3, b = un & 7, p = lane;
        S5Par sp{are[g * 64 + p], aim[g * 64 + p], __expf(ldt[g])}; float Lr, Li; s5_lampow(sp, S5L, Lr, Li);
        float hr = 0.f, hi = 0.f; const size_t base = (size_t)g * S5NC + b * 128;
        for (int c0 = 0; c0 < 128; c0 += 8) { float xr[8], xi[8];
#pragma unroll
            for (int j = 0; j < 8; ++j) { xr[j] = HL[(base + c0 + j) * 128 + p]; xi[j] = HL[(base + c0 + j) * 128 + 64 + p]; }
#pragma unroll
            for (int j = 0; j < 8; ++j) { h16* dst = UG + (base + c0 + j) * S5K3 + 512; dst[p] = (h16)hr; dst[64 + p] = (h16)hi;
                const float nr = Lr * hr - Li * hi + xr[j], ni = Lr * hi + Li * hr + xi[j]; hr = nr; hi = ni; } }
    }
}

DI void attention_units(const Frame& F) { PHASE_IDS
    const h16* P = wsp<h16>(F, WS_PROJ); h16* MIX = wsp<h16>(F, WS_H16);
    LAS unsigned char* sl = F.lds + wave * 16384; LAS h16* qs = (LAS h16*)sl; LAS float* wb = (LAS float*)(sl + 1024);
    for (int un = gw; un < BATCH * 4 * (SEQ / 4); un += NGW) { const int qb = un & 1023, bh = un >> 10, b = bh >> 2, h = bh & 3, t0 = 4 * qb;
        const size_t tokb = (size_t)b * SEQ;
        { const int qi = lane >> 4, d8 = (lane & 15) * 8; *(LAS half8*)(qs + qi * 128 + d8) = *(const half8*)(P + (tokb + t0 + qi) * NIN + 2560 + h * 128 + d8); }
        asm volatile("s_waitcnt vmcnt(0) lgkmcnt(0)" ::: "memory");
        float run[4] = {0.f, 0.f, 0.f, 0.f}, o[4][2] = {{0.f, 0.f}, {0.f, 0.f}, {0.f, 0.f}, {0.f, 0.f}};
        for (int kt = (t0 + 2) >> 6; kt >= 0; --kt) { const int key = 64 * kt + lane;
            const h16* kr = P + (tokb + key) * NIN + 3072 + h * 128; float z[4] = {0.f, 0.f, 0.f, 0.f};
            asm volatile("" ::: "memory");
#pragma unroll 4
            for (int c = 0; c < 16; ++c) { const half8 kv = *(const half8*)(kr + 8 * c);
#pragma unroll
                for (int qi = 0; qi < 4; ++qi) { const half8 qv = *(const LAS half8*)(qs + qi * 128 + 8 * c);
#pragma unroll
                    for (int e = 0; e < 4; ++e) { half2v a2, b2; a2.x = qv[2 * e]; a2.y = qv[2 * e + 1]; b2.x = kv[2 * e]; b2.y = kv[2 * e + 1]; z[qi] = __builtin_amdgcn_fdot2(a2, b2, z[qi], false); } } }
            float mx = -1e30f;
#pragma unroll
            for (int qi = 0; qi < 4; ++qi) { const float zz = z[qi] * 0.08838834764831845f; const bool valid = key < t0 + qi;
                const float ls = valid ? -softplusf_(zz) : 0.f; float inc = ls;
#pragma unroll
                for (int d = 1; d < 64; d <<= 1) { const float tv = __shfl_down(inc, d); inc += (lane + d < 64) ? tv : 0.f; }
                const float after = run[qi] + inc - ls; const float w = valid ? __expf(zz + ls + after) : 0.f;
                run[qi] += __shfl(inc, 0); wb[qi * 64 + lane] = w; mx = fmaxf(mx, run[qi]); }
            asm volatile("s_waitcnt lgkmcnt(0)" ::: "memory");
            const h16* vr = P + (tokb + 64 * kt) * NIN + 3584 + h * 128 + 2 * lane;
#pragma unroll 4
            for (int j4 = 0; j4 < 16; ++j4) { float vx[4], vy[4];
#pragma unroll
                for (int e = 0; e < 4; ++e) { const half2v vv = *(const half2v*)(vr + (size_t)(4 * j4 + e) * NIN); vx[e] = (float)vv.x; vy[e] = (float)vv.y; }
#pragma unroll
                for (int qi = 0; qi < 4; ++qi) { const f32x4 w4 = *(const LAS f32x4*)(wb + qi * 64 + 4 * j4);
#pragma unroll
                    for (int e = 0; e < 4; ++e) { o[qi][0] += w4[e] * vx[e]; o[qi][1] += w4[e] * vy[e]; } } }
            asm volatile("s_waitcnt lgkmcnt(0)" ::: "memory");
            if (mx < -110.f) break;
        }
#pragma unroll
        for (int qi = 0; qi < 4; ++qi) *(unsigned*)(MIX + (tokb + t0 + qi) * DM + 1024 + h * 128 + 2 * lane) = pkh(o[qi][0], o[qi][1]);
    }
}

struct RwIn { f32x4 w; half4 kk, kp, r, a; h16 v; };
DI void rwkv_scan_unit(const Frame& F, int unit) { PHASE_IDS
    const int bh = unit >> 4, rq = unit & 15, b = bh >> 3, h = bh & 7, grp = lane >> 4, sub = lane & 15;
    const int row = rq * 4 + grp, c0 = h * 64 + sub * 4; const size_t tb = (size_t)b * SEQ;
    const float* W = wsp<float>(F, WS_RWW) + tb * DG + c0; const h16* KK = wsp<h16>(F, WS_RWKK) + tb * DG + c0; const h16* KP = wsp<h16>(F, WS_RWKP) + tb * DG + c0;
    const h16* R = wsp<h16>(F, WS_RWR) + tb * DG + c0; const h16* A = wsp<h16>(F, WS_RWA16) + tb * DG + c0; const h16* V = wsp<h16>(F, WS_RWV) + tb * DG + h * 64 + row;
    h16* RAW = wsp<h16>(F, WS_RWRAW) + tb * DG + h * 64 + row;
    float s[4] = {0.f, 0.f, 0.f, 0.f};
    constexpr int U = 4;
    RwIn bufA[U], bufB[U];
#define RW_LOAD(buf, tbase) do { _Pragma("unroll") for (int j = 0; j < U; ++j) { int tt = (tbase) + j; tt = tt < SEQ ? tt : SEQ - 1; const size_t o = (size_t)tt * DG; \
        buf[j].w = *(const f32x4*)(W + o); buf[j].kk = *(const half4*)(KK + o); buf[j].kp = *(const half4*)(KP + o); buf[j].r = *(const half4*)(R + o); buf[j].a = *(const half4*)(A + o); buf[j].v = V[o]; } } while (0)
#define RW_STEP(buf, tbase) do { _Pragma("unroll") for (int j = 0; j < U; ++j) { float kk[4], kka[4], kp[4], r[4]; const float vv = (float)buf[j].v; \
        _Pragma("unroll") for (int e = 0; e < 4; ++e) { kk[e] = (float)buf[j].kk[e]; kka[e] = kk[e] * (float)buf[j].a[e]; kp[e] = (float)buf[j].kp[e]; r[e] = (float)buf[j].r[e]; } \
        float sa = (s[0] * kk[0] + s[1] * kk[1]) + (s[2] * kk[2] + s[3] * kk[3]); sa = sum16(sa); \
        float ov = 0.f; \
        _Pragma("unroll") for (int e = 0; e < 4; ++e) { s[e] = s[e] * buf[j].w[e] + (vv * kp[e] - sa * kka[e]); ov += s[e] * r[e]; } \
        ov = sum16(ov); if (sub == 0) RAW[(size_t)((tbase) + j) * DG] = (h16)ov; } } while (0)
    RW_LOAD(bufA, 0);
    for (int t0 = 0; t0 < SEQ; t0 += 2 * U) {
        RW_LOAD(bufB, t0 + U);
        RW_STEP(bufA, t0);
        RW_LOAD(bufA, t0 + 2 * U);
        RW_STEP(bufB, t0 + U);
    }
#undef RW_LOAD
#undef RW_STEP
}
struct HgIn { half8 k, q; h16 v; };
DI void hgrn_scan_unit(const Frame& F, int unit) { PHASE_IDS
    const int bh = unit >> 5, vq = unit & 31, b = bh >> 2, h = bh & 3, grp = lane >> 4, sub = lane & 15;
    const int vcol = vq * 4 + grp, c0 = h * 128 + sub * 8; const size_t tb = (size_t)b * SEQ;
    const h16* K = wsp<h16>(F, WS_HGK) + tb * DG + c0; const h16* Q = wsp<h16>(F, WS_HGQ) + tb * DG + c0;
    const h16* V = wsp<h16>(F, WS_PROJ) + tb * NIN + 1024 + h * 128 + vcol; h16* RAW = wsp<h16>(F, WS_HGRAW) + tb * DG + h * 128 + vcol;
    float s[8] = {0.f, 0.f, 0.f, 0.f, 0.f, 0.f, 0.f, 0.f};
    constexpr int U = 4;
    HgIn bufA[U], bufB[U];
#define HG_LOAD(buf, tbase) do { _Pragma("unroll") for (int j = 0; j < U; ++j) { int tt = (tbase) + j; tt = tt < SEQ ? tt : SEQ - 1; \
        buf[j].k = *(const half8*)(K + (size_t)tt * DG); buf[j].q = *(const half8*)(Q + (size_t)tt * DG); buf[j].v = V[(size_t)tt * NIN]; } } while (0)
#define HG_STEP(buf, tbase) do { _Pragma("unroll") for (int j = 0; j < U; ++j) { const float vv = (float)buf[j].v; float ov = 0.f; \
        _Pragma("unroll") for (int e = 0; e < 8; ++e) { const float k = (float)buf[j].k[e]; s[e] = s[e] * (1.f - k) + k * vv; ov += s[e] * (float)buf[j].q[e]; } \
        ov = sum16(ov); if (sub == 0) RAW[(size_t)((tbase) + j) * DG] = (h16)ov; } } while (0)
    HG_LOAD(bufA, 0);
    for (int t0 = 0; t0 < SEQ; t0 += 2 * U) {
        HG_LOAD(bufB, t0 + U);
        HG_STEP(bufA, t0);
        HG_LOAD(bufA, t0 + 2 * U);
        HG_STEP(bufB, t0 + U);
    }
#undef HG_LOAD
#undef HG_STEP
}
DI void finalize_rows(const Frame& F, int l) { PHASE_IDS
    const h16* P = wsp<h16>(F, WS_PROJ); h16* MIX = wsp<h16>(F, WS_H16);
    const h16* RAW = wsp<h16>(F, WS_RWRAW); const h16* R = wsp<h16>(F, WS_RWR); const h16* KP = wsp<h16>(F, WS_RWKP); const h16* V = wsp<h16>(F, WS_RWV); const h16* GG = wsp<h16>(F, WS_LR16);
    const h16* HRAW = wsp<h16>(F, WS_HGRAW);
    const int c0 = 8 * lane;
    float rk[8], gg[8], gb[8], ng[8];
#pragma unroll
    for (int j = 0; j < 8; ++j) { rk[j] = inp(F, I_RWRK)[l * DG + c0 + j]; gg[j] = inp(F, I_RWGNG)[l * DG + c0 + j]; gb[j] = inp(F, I_RWGNB)[l * DG + c0 + j]; ng[j] = inp(F, I_HGNG)[l * DG + c0 + j]; }
    for (int row = gw; row < M; row += NGW) { const size_t ro = (size_t)row * DG + c0;
        { float x[8], r[8], kp[8], v[8], g[8]; h8_to_f(*(const half8*)(RAW + ro), x); h8_to_f(*(const half8*)(R + ro), r); h8_to_f(*(const half8*)(KP + ro), kp); h8_to_f(*(const half8*)(V + ro), v); h8_to_f(*(const half8*)(GG + (size_t)row * 1536 + 1024 + c0), g);
            float s = 0.f, bs = 0.f;
#pragma unroll
            for (int j = 0; j < 8; ++j) { s += x[j]; bs += r[j] * kp[j] * rk[j]; }
            s = sum8(s); bs = sum8(bs); const float mean = s * (1.f / 64.f); float q = 0.f;
#pragma unroll
            for (int j = 0; j < 8; ++j) { x[j] -= mean; q += x[j] * x[j]; }
            q = sum8(q); const float rstd = rsqrtf_(q * (1.f / 64.f) + opq_f(GN_EPS)); float o[8];
#pragma unroll
            for (int j = 0; j < 8; ++j) o[j] = (x[j] * rstd * gg[j] + gb[j] + bs * v[j]) * g[j];
            *(half8*)(MIX + (size_t)row * DM + 1536 + c0) = f_to_h8(o); }
        { float x[8], g[8]; h8_to_f(*(const half8*)(HRAW + ro), x); h8_to_f(*(const half8*)(P + (size_t)row * NIN + 1536 + c0), g);
            float q = 0.f;
#pragma unroll
            for (int j = 0; j < 8; ++j) q += x[j] * x[j];
            q = sum16(q); const float rr = rsqrtf_(q * (1.f / 128.f) + opq_f(RMS_EPS)); float o[8];
#pragma unroll
            for (int j = 0; j < 8; ++j) o[j] = x[j] * rr * ng[j] * siluf_(g[j]);
            *(half8*)(MIX + (size_t)row * DM + c0) = f_to_h8(o); }
    }
}

constexpr int PH_PER_LAYER = 11, N_PHASES = 2 + DEPTH * PH_PER_LAYER;
__global__ void __launch_bounds__(NWAVES * 64, 2) hse_fwd(Args args) {
    extern __shared__ __attribute__((aligned(16))) unsigned char lds_raw[];
    Frame F;
    F.lds = (LAS unsigned char*)lds_raw;
    const int G = gridDim.x, wave = __builtin_amdgcn_readfirstlane(threadIdx.x >> 6);
    F.ws = args.ws; F.out = args.out; F.wave = wave;
    volatile LAS unsigned* MISC = (volatile LAS unsigned*)(F.lds + MISC_OFF);
    if (threadIdx.x < 16) MISC[threadIdx.x] = 0u;
    __syncthreads();
#if MK_LAUNCH_MODE == 0
    XcdBarrier bar = xcd_barrier_post((unsigned*)(F.ws + WS_CTL) + CW_BAR, MISC + 8, wave);
#define GRID_BAR() xcd_barrier(bar)
#else
#define GRID_BAR() do {} while (0)
#endif
    const int lo = args.ph_lo, hi = args.ph_hi;
#define IN(k) (lo <= (k) && (k) < hi)
#define SEAM(k) do { if (IN((k) + 1)) GRID_BAR(); } while (0)
#define MOD wsp<float>(F, WS_MOD)
#define X wsp<float>(F, WS_X)
#define H16 wsp<h16>(F, WS_H16)
#define PROJ wsp<h16>(F, WS_PROJ)
    LAS unsigned char* ring = F.lds;

    if (PHE(11) && IN(0)) { p0_mod(F); convert_weights(F, 0); SEAM(0); }
    if (PHE(12) && IN(1)) { modulate_rows(F, inp(F, I_X), MOD, 0, H16); SEAM(1); }

    for (int l = 0; l < DEPTH; ++l) {
        const int pb = 2 + l * PH_PER_LAYER;
#define modl (MOD + (size_t)l * BATCH * MODW)
        if (PHE(0) && IN(pb + 0)) { pg8::Gemm g{H16, wsp<h16>(F, WS_WIN), DM, DM, DM, 0, 0}; pg8::StaticOrder S; S.init(M, NIN, G, opq_bid());
            pg8::EpiProj E{PROJ, wsp<h16>(F, WS_UG)}; pg8::gemm_phase<pg8::EpiProj, pg8::StaticOrder, true>(ring, g, S, E, wave); SEAM(pb + 0); }
        if (PHE(1) && IN(pb + 1)) { { pg8::Gemm g{wsp<h16>(F, WS_UG), wsp<h16>(F, WS_S5T1), S5K3, 512, 512, (long)S5NC * S5K3, 256L * 512}; pg8::GroupOrder S; S.init(4, 1, 32, G, opq_bid());
                pg8::EpiS5h E{wsp<float>(F, WS_HLOC)}; if (PHE(15)) pg8::gemm_phase<pg8::EpiS5h, pg8::GroupOrder, true>(ring, g, S, E, wave); }
            __syncthreads();
            if (PHE(14)) prep_rows(F, l); if (PHE(13)) attention_units(F); SEAM(pb + 1); }
        if (PHE(2) && IN(pb + 2)) { { pg8::Gemm g{wsp<h16>(F, WS_RWA), wsp<h16>(F, WS_LRT), 256, 256, 256, 0, 0}; pg8::StaticOrder S; S.init(M, 1536, G, opq_bid());
                pg8::EpiLR E{wsp<h16>(F, WS_LR16)};
                if (PHE(17)) pg8::gemm_phase<pg8::EpiLR, pg8::StaticOrder, true>(ring, g, S, E, wave); }
            if (PHE(16)) s5_chunk_scan(F, l); SEAM(pb + 2); }
        if (PHE(3) && IN(pb + 3)) { { pg8::Gemm g{wsp<h16>(F, WS_UG), wsp<h16>(F, WS_S5T3), S5K3, S5K3, S5K3, (long)S5NC * S5K3, 512L * S5K3}; pg8::GroupOrder S; S.init(4, 2, 32, G, opq_bid());
                pg8::EpiS5y E{PROJ, inp(F, I_S5D) + l * DG, wsp<h16>(F, WS_Y16)}; pg8::gemm_phase<pg8::EpiS5y, pg8::GroupOrder, true>(ring, g, S, E, wave); }
            rwkv_prep_rows(F, l); SEAM(pb + 3); }
        if (PHE(4) && IN(pb + 4)) { if (wave < 4) { for (int un = opq_bid() * 4 + wave; un < 1024; un += G * 4) rwkv_scan_unit(F, un); }
            else { for (int un = opq_bid() * 4 + wave - 4; un < 1024; un += G * 4) hgrn_scan_unit(F, un); }
            SEAM(pb + 4); }
        if (PHE(5) && IN(pb + 5)) { { pg8::Gemm g{wsp<h16>(F, WS_Y16), wsp<h16>(F, WS_GLU), DG, DG, DG, 0, 0}; pg8::StaticOrder S; S.init(M, DG, G, opq_bid());
                pg8::EpiGLU E{wsp<h16>(F, WS_Y16), inp(F, I_GLUB) + l * DG, H16}; pg8::gemm_phase<pg8::EpiGLU, pg8::StaticOrder, true>(ring, g, S, E, wave); }
            finalize_rows(F, l); SEAM(pb + 5); }
        if (PHE(6) && IN(pb + 6)) { pg8::Gemm g{H16, wsp<h16>(F, WS_WOUT), DM, DM, DM, 0, 0}; pg8::StaticOrder S; S.init(M, DM, G, opq_bid());
            pg8::EpiRes E{l == 0 ? inp(F, I_X) : X, X, modl + 2 * DM}; pg8::gemm_phase<pg8::EpiRes, pg8::StaticOrder, true>(ring, g, S, E, wave); SEAM(pb + 6); }
        if (PHE(7) && IN(pb + 7)) { ln_rows(F, X, X, inp(F, I_LN1G) + l * DM, inp(F, I_LN1B) + l * DM, modl, 3, H16); SEAM(pb + 7); }
        if (PHE(8) && IN(pb + 8)) { pg8::Gemm g{H16, wsp<h16>(F, WS_W13), DM, DM, DM, 0, 0}; pg8::StaticOrder S; S.init(M, 2 * DFF, G, opq_bid());
            pg8::EpiSwiGLU E{PROJ}; pg8::gemm_phase<pg8::EpiSwiGLU, pg8::StaticOrder, true>(ring, g, S, E, wave); SEAM(pb + 8); }
        if (PHE(9) && IN(pb + 9)) { pg8::Gemm g{PROJ, wsp<h16>(F, WS_W2), DFF, DFF, DFF, 0, 0}; pg8::StaticOrder S; S.init(M, DM, G, opq_bid());
            pg8::EpiRes E{X, X, modl + 5 * DM}; pg8::gemm_phase<pg8::EpiRes, pg8::StaticOrder, true>(ring, g, S, E, wave); SEAM(pb + 9); }
        if (PHE(10) && IN(pb + 10)) { const bool lastl = (l == DEPTH - 1);
            ln_rows(F, X, lastl ? F.out : X, inp(F, I_LN2G) + l * DM, inp(F, I_LN2B) + l * DM, modl + (size_t)BATCH * MODW, 0, lastl ? (h16*)nullptr : H16);
            if (!lastl) { __syncthreads(); convert_weights(F, l + 1); }
            SEAM(pb + 10); }
    }
#undef IN
#undef SEAM
#undef MOD
#undef X
#undef H16
#undef PROJ
#undef modl
}

extern "C" void kernel_launch(void* const* d_in, const int* in_sizes, int n_in, void* d_out, int out_size, void* d_ws, size_t ws_size, hipStream_t stream) {
    static int grid = 0;
    if (grid == 0) {
        if (n_in != 36 || in_sizes[0] != M * DM || out_size != M * DM || ws_size < WS_END) { fprintf(stderr, "kernel_launch: unexpected shapes (n_in %d, in0 %d, out %d, ws %zu)\n", n_in, n_in > 0 ? in_sizes[0] : -1, out_size, ws_size); grid = -1; return; }
        int dev = 0, cus = 0, per_cu = 0;
        if (hipGetDevice(&dev) != hipSuccess || hipDeviceGetAttribute(&cus, hipDeviceAttributeMultiprocessorCount, dev) != hipSuccess) { grid = -1; return; }
        if (hipFuncSetAttribute((const void*)hse_fwd, hipFuncAttributeMaxDynamicSharedMemorySize, LDS_BYTES) != hipSuccess) { fprintf(stderr, "kernel_launch: hipFuncSetAttribute failed\n"); grid = -1; return; }
        if (hipOccupancyMaxActiveBlocksPerMultiprocessor(&per_cu, (const void*)hse_fwd, NWAVES * 64, LDS_BYTES) != hipSuccess || per_cu < 1) { fprintf(stderr, "kernel_launch: occupancy query reports %d\n", per_cu); }
        (void)hipGetLastError();
        grid = cus;
    }
    if (grid < 0) return;
    if (hipMemsetAsync((char*)d_ws + WS_CTL, 0, CTL_ZERO_BYTES, stream) != hipSuccess) return;
    Args a{};
    for (int i = 0; i < 36; ++i) a.in[i] = (const float*)d_in[i];
    a.out = (float*)d_out; a.ws = (unsigned char*)d_ws;
#if MK_LAUNCH_MODE == 0
    a.ph_lo = 0; a.ph_hi = N_PHASES;
    hipLaunchKernelGGL(hse_fwd, dim3(grid), dim3(NWAVES * 64), LDS_BYTES, stream, a);
#else
    for (int p = 0; p < N_PHASES; ++p) { a.ph_lo = p; a.ph_hi = p + 1; hipLaunchKernelGGL(hse_fwd, dim3(grid), dim3(NWAVES * 64), LDS_BYTES, stream, a); }
#endif
}
```

```cpp
#include <hip/hip_runtime.h>
#include <cstdio>
#include <cstdint>

#ifndef MK_LAUNCH_MODE
#define MK_LAUNCH_MODE 0
#endif

#ifndef PH_ENABLE
#define PH_ENABLE 0xFFFFF
#endif
#define PHE(k) (((PH_ENABLE) >> (k)) & 1)
#ifndef REPEAT_MASK
#define REPEAT_MASK 0
#endif
#define REPB(k, ...) do { __VA_ARGS__ if ((REPEAT_MASK >> (k)) & 1) { __syncthreads(); __VA_ARGS__ } } while (0)
#define LAS __attribute__((address_space(3)))
typedef _Float16 h16;
typedef _Float16 half8 __attribute__((ext_vector_type(8)));
typedef _Float16 half4 __attribute__((ext_vector_type(4)));
typedef _Float16 half2v __attribute__((ext_vector_type(2)));
typedef float f32x4 __attribute__((ext_vector_type(4)));
typedef float f32x2 __attribute__((ext_vector_type(2)));
typedef unsigned u32x4 __attribute__((ext_vector_type(4)));
typedef unsigned u32x2 __attribute__((ext_vector_type(2)));

constexpr int BATCH = 8, SEQ = 4096, DM = 2048, DEPTH = 4, M = BATCH * SEQ;
constexpr int DG = 512, NIN = 5888, RWOFF = 4096, DFF = 5632;
constexpr int MODW = 6 * DM;
constexpr float DN_ALPHA = 1.681792830507429f;
constexpr float LN_EPS = 1e-5f, RMS_EPS = 1e-6f, GN_EPS = 64e-5f;
constexpr int S5L = 32, S5NC = M / S5L;
constexpr int S5K3 = 640;

constexpr size_t MiB = 1u << 20;
constexpr size_t WS_CTL = 0, CTL_ZERO_BYTES = 64 * 1024;
constexpr size_t WS_MOD = 1 * MiB;
constexpr size_t WS_LB = 3 * MiB;
constexpr size_t WS_W16 = 16 * MiB;
constexpr size_t WS_WIN = WS_W16;
constexpr size_t WS_WOUT = WS_WIN + 23 * MiB;
constexpr size_t WS_W13 = WS_WOUT + 8 * MiB;
constexpr size_t WS_W2 = WS_W13 + 44 * MiB;
constexpr size_t WS_GLU = WS_W2 + 22 * MiB;
constexpr size_t WS_LRT = WS_GLU + 1 * MiB;
constexpr size_t WS_S5T3 = WS_LRT + 1 * MiB;
constexpr size_t WS_S5T1 = WS_S5T3 + 20 * MiB;
constexpr size_t WS_X = 152 * MiB;
constexpr size_t WS_H16 = 408 * MiB;
constexpr size_t WS_PROJ = 536 * MiB;
constexpr size_t WS_RWA = 904 * MiB;
constexpr size_t WS_HLOC = 920 * MiB;
constexpr size_t WS_Y16 = 904 * MiB;
constexpr size_t WS_LR16 = 936 * MiB;
constexpr size_t WS_RWREC = 1032 * MiB;
constexpr size_t WS_RWBON = 1240 * MiB;
constexpr size_t WS_HGK = 1256 * MiB;
constexpr size_t WS_HGQ = 1288 * MiB;
constexpr size_t WS_HGST = 1320 * MiB;
constexpr size_t WS_UG = 1384 * MiB;
constexpr size_t WS_RWRAW = 1384 * MiB;
constexpr size_t WS_LNST = 8 * MiB;
constexpr size_t WS_LPW = 6 * MiB;
constexpr size_t WS_BBR = 7 * MiB;
constexpr size_t WS_HGB = 4 * MiB;
constexpr size_t WS_END = 1424 * MiB;
static_assert(WS_S5T1 + 8 * MiB <= WS_X, "W16 map");
constexpr int CW_BAR = 1024;

constexpr int RING_BYTES = 131072, MISC_OFF = RING_BYTES + 64, LDS_BYTES = 147456;
constexpr int NWAVES = 8;

#define DI __device__ __forceinline__
DI int opq_lane() { int l; asm volatile("v_mbcnt_lo_u32_b32 %0, -1, 0\n\tv_mbcnt_hi_u32_b32 %0, -1, %0" : "=v"(l)); return l; }
DI unsigned pkh(float a, float b) { half2v h; h.x = (h16)a; h.y = (h16)b; return __builtin_bit_cast(unsigned, h); }
DI float sigmoidf_(float x) { return __builtin_amdgcn_rcpf(1.f + __expf(-x)); }
DI float siluf_(float x) { return x * sigmoidf_(x); }
DI float tanhf_(float x) { const float t = __expf(-2.f * fabsf(x)); const float r = (1.f - t) * __builtin_amdgcn_rcpf(1.f + t); return x < 0.f ? -r : r; }
DI float softplusf_(float x) { return fmaxf(x, 0.f) + 0.6931471805599453f * __builtin_amdgcn_logf(1.f + __expf(-fabsf(x))); }
DI float rsqrtf_(float x) { return __builtin_amdgcn_rsqf(x); }
DI float gelu_tanhf_(float y) { const float u = 1.5957691216057308f * (y + 0.044715f * y * y * y); return y * sigmoidf_(u); }
template <int CTRL> DI float dppf(float v) { return __builtin_bit_cast(float, __builtin_amdgcn_update_dpp(0, __builtin_bit_cast(int, v), CTRL, 0xf, 0xf, false)); }
DI float sum4(float v) { v += dppf<0xB1>(v); v += dppf<0x4E>(v); return v; }
DI float sum8(float v) { v = sum4(v); v += dppf<0x141>(v); return v; }
DI float sum16(float v) { v = sum8(v); v += dppf<0x140>(v); return v; }
DI float wave_sum(float v) {
#pragma unroll
    for (int o = 1; o < 64; o <<= 1) v += __shfl_xor(v, o);
    return v;
}
typedef short bf16x8 __attribute__((ext_vector_type(8)));
typedef short bf16x4 __attribute__((ext_vector_type(4)));
DI unsigned short f2bf(float f) { unsigned u = __builtin_bit_cast(unsigned, f); return (unsigned short)((u + 0x7fffu + ((u >> 16) & 1u)) >> 16); }
DI float bf2f(unsigned short b) { return __builtin_bit_cast(float, (unsigned)b << 16); }
DI void h8_to_f(const half8 h, float (&f)[8]) {
#pragma unroll
    for (int i = 0; i < 8; ++i) f[i] = (float)h[i];
}
DI half8 f_to_h8(const float (&f)[8]) { half8 h;
#pragma unroll
    for (int i = 0; i < 8; ++i) h[i] = (h16)f[i];
    return h; }

#define XB_TMO      128
#define XB_XCNT(j)  (256  + 64 * (j))
#define XB_XSUB(j)  (1280 + 64 * (j))
#define XB_XGEN(j)  (2304 + 64 * (j))
#define XB_TOP      3328
#define XB_TOPGEN   3392
#define XCD_BAR_WORDS 3456
#define XB_SPIN_CAP (1u << 20)
__device__ __forceinline__ unsigned xb_ld(unsigned* p)              { return __hip_atomic_load(p, __ATOMIC_RELAXED, __HIP_MEMORY_SCOPE_AGENT); }
__device__ __forceinline__ unsigned xb_add(unsigned* p, unsigned v) { return __hip_atomic_fetch_add(p, v, __ATOMIC_RELAXED, __HIP_MEMORY_SCOPE_AGENT); }
__device__ __forceinline__ unsigned xb_xcc_id() { return (unsigned)__builtin_amdgcn_s_getreg((3 << 11) | 20) & 0xFu; }
#define XB_SPIN(cond, bar) do { unsigned _sp = 0; while (cond) { __builtin_amdgcn_s_sleep(1); \
    if ((++_sp & 255u) == 0u) { if (xb_ld(&(bar)[XB_TMO])) break; if (_sp > XB_SPIN_CAP) { atomicAdd(&(bar)[XB_TMO], 1u); break; } } } } while (0)
struct XcdBarrier { unsigned* bar; unsigned x; volatile LAS unsigned* st; int wave; };
__device__ __forceinline__ XcdBarrier xcd_barrier_post(unsigned* bar, volatile LAS unsigned* st, int wave) {
    XcdBarrier b; b.bar = bar; b.x = xb_xcc_id(); b.st = st; b.wave = wave;
    if (wave == 0 && opq_lane() == 0) (void)xb_add(&bar[XB_XCNT(b.x)], 1u);
    return b;
}
__device__ __forceinline__ void xcd_barrier_complete(unsigned* bar, unsigned x, unsigned& nloc, unsigned& nx) {
    const unsigned G = gridDim.x * gridDim.y * gridDim.z;
    asm volatile("" : "+s"(x));
    unsigned sum, cnt, mine, sp = 0u;
    for (;;) {
        sum = 0u; cnt = 0u; mine = 0u;
#pragma unroll
        for (unsigned j = 0; j < 16; ++j) { const unsigned c = xb_ld(&bar[XB_XCNT(j)]); sum += c; cnt += (c > 0u) ? 1u : 0u; mine = (j == x) ? c : mine; }
        if (sum == G) break;
        __builtin_amdgcn_s_sleep(1);
        if ((++sp & 255u) == 0u) { if (xb_ld(&bar[XB_TMO])) break; if (sp > XB_SPIN_CAP) { atomicAdd(&bar[XB_TMO], 1u); break; } }
    }
    nloc = mine > 0u ? mine : 1u; nx = cnt > 0u ? cnt : 1u;
}
__device__ __forceinline__ void xcd_barrier(const XcdBarrier& b) {
    asm volatile("s_waitcnt vmcnt(0)" ::: "memory");
    __syncthreads();
    if (b.wave == 0 && opq_lane() == 0) {
        unsigned* bar = b.bar; asm volatile("" : "+s"(bar));
        __builtin_amdgcn_s_waitcnt(0);
        unsigned nloc = b.st[0], nx = b.st[1];
        if (nloc == 0u) { xcd_barrier_complete(bar, b.x, nloc, nx); b.st[0] = nloc; b.st[1] = nx; }
        const unsigned old = xb_add(&bar[XB_XSUB(b.x)], 1u);
        const unsigned gen = old / nloc;
        if (old + 1u == (gen + 1u) * nloc) {
            __builtin_amdgcn_fence(__ATOMIC_RELEASE, "agent");
            asm volatile("s_waitcnt vmcnt(0)" ::: "memory");
            const unsigned og = xb_add(&bar[XB_TOP], 1u);
            const unsigned tg = og / nx;
            if (og + 1u == (tg + 1u) * nx) xb_add(&bar[XB_TOPGEN], 1u);
            else XB_SPIN(xb_ld(&bar[XB_TOPGEN]) == tg, bar);
            __builtin_amdgcn_fence(__ATOMIC_ACQUIRE, "agent");
            xb_add(&bar[XB_XGEN(b.x)], 1u);
            asm volatile("s_waitcnt vmcnt(0)" ::: "memory");
        } else {
            XB_SPIN(xb_ld(&bar[XB_XGEN(b.x)]) == gen, bar);
            __builtin_amdgcn_fence(__ATOMIC_ACQUIRE, "agent");
            asm volatile("s_waitcnt vmcnt(0)" ::: "memory");
        }
    }
    __syncthreads();
}

namespace pg8 {
constexpr int BM = 256, BK = 64, HALF = 128, HTB = HALF * BK * 2, STAGE_BYTES = 8 * HTB, NXCD = 8, WGM = 8;
__host__ __device__ __forceinline__ int lds_byte(int r, int c) { const int st = (r >> 4) * 2 + (c >> 5), rr = r & 15, cc = c & 31, ob = rr * 64 + cc * 2; return st * 1024 + (ob ^ (((ob >> 9) & 1) << 5)); }
__host__ __device__ __forceinline__ void stage_rc(int b, int& R, int& C) { const int st = b / 1024, sb = b % 1024, swz = sb ^ (((sb >> 9) & 1) << 5); R = (st >> 1) * 16 + swz / 64; C = (st & 1) * 32 + (swz % 64) / 2; }
__host__ __device__ __forceinline__ int perm32(int rho) { const int n = rho >> 4, i = rho & 15; return 8 * (i >> 2) + 4 * n + (i & 3); }

struct Unit { int pm, pn, g; };
struct Gemm { const h16* A; const h16* Bt; int lda, ldb, K; long gsA, gsB; };

struct StaticOrder {
    int nM, nN, nwg, G, c;
    __device__ void init(int M_, int N_, int G_, int c_) { nM = M_ / BM; nN = N_ / BM; nwg = nM * nN; G = G_; c = c_; }
    __device__ bool next(int i, Unit& u) const {
        const long L = (long)i * G + c; if (L >= nwg) return false;
        int wgid = (int)L; { const int q = nwg / NXCD, r = nwg % NXCD, xcd = wgid % NXCD, off = wgid / NXCD; wgid = (xcd < r ? xcd * (q + 1) : r * (q + 1) + (xcd - r) * q) + off; }
        const int nig = WGM * nN, gid = wgid / nig, fm = gid * WGM, gsz = (nM - fm) < WGM ? (nM - fm) : WGM;
        u.pm = fm + ((wgid % nig) % gsz); u.pn = (wgid % nig) / gsz; u.g = 0; return true;
    }
};
struct GroupOrder {
    int nM, nN, per, total, G, c;
    __device__ void init(int nM_, int nN_, int ng, int G_, int c_) { nM = nM_; nN = nN_; per = nM_ * nN_; total = per * ng; G = G_; c = c_; }
    __device__ bool next(int i, Unit& u) const {
        const long L = (long)i * G + c; if (L >= total) return false;
        const int l = (int)L; u.g = l / per; const int r = l % per; u.pm = r % nM; u.pn = r / nM; return true;
    }
};

__device__ __forceinline__ void glds16_s(const char* gbase, unsigned voff, unsigned lds_dst) {
    unsigned keep;
    asm volatile("s_mov_b32 %0, m0\n\ts_mov_b32 m0, %2\n\ts_nop 0\n\tglobal_load_lds_dwordx4 %1, %3\n\ts_mov_b32 m0, %0" : "=&s"(keep) : "v"(voff), "s"(lds_dst), "s"(gbase) : "memory");
}
template <class Epi, class Sched, bool ALIGN_EPI>
__device__ __forceinline__ void gemm_phase(LAS unsigned char* lds, const Gemm g, const Sched& S, const Epi& E, const int wid_in) {
    int lane; asm volatile("v_mbcnt_lo_u32_b32 %0, -1, 0\n\tv_mbcnt_hi_u32_b32 %0, -1, %0" : "=v"(lane));
    int wid = wid_in; asm volatile("" : "+s"(wid));
    const int tid = wid * 64 + lane, wr = wid >> 2, wc = wid & 3, fr = lane & 15, fq = lane >> 4;
    const int K = g.K, nt = K / BK;
    unsigned voffA[2], voffB[2];
#pragma unroll
    for (int i = 0; i < 2; ++i) { int R, C; stage_rc(tid * 16 + i * 8192, R, C); const int Rb = Epi::PERM ? ((R & ~31) + perm32(R & 31)) : R;
        voffA[i] = (unsigned)(R * g.lda + C) * 2u; voffB[i] = (unsigned)(Rb * g.ldb + C) * 2u; }
    const size_t kstep = (size_t)(BK * 2);
    const size_t hstepA = (size_t)HALF * g.lda * 2, hstepB = (size_t)HALF * g.ldb * 2;
    const size_t tstepA = 2 * hstepA, tstepB = 2 * hstepB;
    const unsigned ldsw = (unsigned)wid * 1024u, lds_u = (unsigned)(size_t)lds;
    const int aoff = lds_byte(wr * 64 + fr, fq * 8), boff = lds_byte(wc * 32 + fr, fq * 8);
#define PG8_SA(b, h) (((b) * 2 + (h)) * HTB)
#define PG8_SB(b, h) ((4 + (b) * 2 + (h)) * HTB)
#define PG8_STAGE(bufoff, gbase, voff) do { _Pragma("unroll") for (int _i = 0; _i < 2; ++_i) glds16_s((const char*)(gbase), (voff)[_i], lds_u + (unsigned)((bufoff) + _i * 8192) + ldsw); } while (0)
#define PG8_LDA(dst, b, h) do { _Pragma("unroll") for (int m = 0; m < 4; ++m) _Pragma("unroll") for (int k = 0; k < 2; ++k) dst[m][k] = *(const LAS half8*)(lds + PG8_SA(b, h) + aoff + m * 2048 + k * 1024); } while (0)
#define PG8_LDB(dst, b, h) do { _Pragma("unroll") for (int n = 0; n < 2; ++n) _Pragma("unroll") for (int k = 0; k < 2; ++k) dst[n][k] = *(const LAS half8*)(lds + PG8_SB(b, h) + boff + n * 2048 + k * 1024); } while (0)
#define PG8_MMA(ai, bj, At, Bt) do { __builtin_amdgcn_s_setprio(1); _Pragma("unroll") for (int m = 0; m < 4; ++m) _Pragma("unroll") for (int n = 0; n < 2; ++n) _Pragma("unroll") for (int k = 0; k < 2; ++k) \
        acc[ai][bj][m][n] = __builtin_amdgcn_mfma_f32_16x16x32_f16(Bt[n][k], At[m][k], acc[ai][bj][m][n], 0, 0, 0); __builtin_amdgcn_s_setprio(0); } while (0)
#define PG8_WAIT_V(n) asm volatile("s_waitcnt vmcnt(" #n ")" ::: "memory")
#define PG8_WAIT_L(n) asm volatile("s_waitcnt lgkmcnt(" #n ")" ::: "memory")
#define PG8_BAR __builtin_amdgcn_s_barrier()
#define PG8_SCHED __builtin_amdgcn_sched_barrier(0)
    Unit cur, nxt; int ui = 0;
    if (!S.next(0, cur)) return;
    f32x4 acc[2][2][4][2];
#pragma unroll
    for (int a = 0; a < 2; ++a)
#pragma unroll
        for (int b = 0; b < 2; ++b)
#pragma unroll
            for (int m = 0; m < 4; ++m)
#pragma unroll
                for (int n = 0; n < 2; ++n) acc[a][b][m][n] = (f32x4){0.f, 0.f, 0.f, 0.f};
    half8 At[4][2], B0[2][2], B1[2][2];
    const char* cA = (const char*)g.A + (size_t)cur.g * g.gsA * 2 + (size_t)cur.pm * tstepA;
    const char* cB = (const char*)g.Bt + (size_t)cur.g * g.gsB * 2 + (size_t)cur.pn * tstepB;
    PG8_STAGE(PG8_SB(0, 0), cB, voffB); PG8_STAGE(PG8_SB(0, 1), cB + hstepB, voffB); PG8_STAGE(PG8_SA(0, 0), cA, voffA); PG8_STAGE(PG8_SA(0, 1), cA + hstepA, voffA);
    if (wr == 1) PG8_BAR;
    PG8_WAIT_V(2); PG8_BAR;
    PG8_STAGE(PG8_SB(1, 0), cB + kstep, voffB); PG8_STAGE(PG8_SA(1, 0), cA + kstep, voffA); PG8_STAGE(PG8_SB(1, 1), cB + hstepB + kstep, voffB);
    PG8_WAIT_V(6); PG8_BAR;
    for (;;) {
        const bool has_next = S.next(ui + 1, nxt);
        const char* nA = has_next ? (const char*)g.A + (size_t)nxt.g * g.gsA * 2 + (size_t)nxt.pm * tstepA : cA;
        const char* nB = has_next ? (const char*)g.Bt + (size_t)nxt.g * g.gsB * 2 + (size_t)nxt.pn * tstepB : cB;
        for (int t = 0; t < nt; t += 2) {
            const bool last = (t == nt - 2);
            const char* a1 = cA + (size_t)(t + 1) * kstep;
            const char* a2 = last ? nA : cA + (size_t)(t + 2) * kstep; const char* b2 = last ? nB : cB + (size_t)(t + 2) * kstep;
            const char* a3 = a2 + kstep; const char* b3 = b2 + kstep;
            PG8_LDB(B0, 0, 0); PG8_LDB(B1, 0, 1); PG8_SCHED; PG8_LDA(At, 0, 0); PG8_STAGE(PG8_SA(1, 1), a1 + hstepA, voffA);
            PG8_WAIT_V(8); PG8_WAIT_L(0); PG8_BAR; PG8_MMA(0, 0, At, B0); PG8_MMA(0, 1, At, B1); PG8_BAR; PG8_SCHED;
            PG8_LDA(At, 0, 1); PG8_STAGE(PG8_SB(0, 0), b2, voffB); PG8_STAGE(PG8_SB(0, 1), b2 + hstepB, voffB); PG8_STAGE(PG8_SA(0, 0), a2, voffA);
            PG8_WAIT_V(8); PG8_WAIT_L(0); PG8_BAR; PG8_MMA(1, 0, At, B0); PG8_MMA(1, 1, At, B1); PG8_BAR; PG8_SCHED;
            PG8_LDB(B0, 1, 0); PG8_LDB(B1, 1, 1); PG8_SCHED; PG8_LDA(At, 1, 0); PG8_STAGE(PG8_SA(0, 1), a2 + hstepA, voffA);
            PG8_WAIT_V(8); PG8_WAIT_L(0); PG8_BAR; PG8_MMA(0, 0, At, B0); PG8_MMA(0, 1, At, B1); PG8_BAR; PG8_SCHED;
            PG8_LDA(At, 1, 1); PG8_STAGE(PG8_SB(1, 0), b3, voffB); PG8_STAGE(PG8_SB(1, 1), b3 + hstepB, voffB); PG8_STAGE(PG8_SA(1, 0), a3, voffA);
            PG8_WAIT_V(8); PG8_WAIT_L(0); PG8_BAR; PG8_MMA(1, 0, At, B0); PG8_MMA(1, 1, At, B1); PG8_BAR; PG8_SCHED;
        }
        if constexpr (ALIGN_EPI) { if (wr == 0) PG8_BAR; }
        { int ln2; asm volatile("v_mbcnt_lo_u32_b32 %0, -1, 0\n\tv_mbcnt_hi_u32_b32 %0, -1, %0" : "=v"(ln2)); E(acc, cur, wr, wc, ln2 & 15, ln2 >> 4); }
        if (!has_next) break;
#pragma unroll
        for (int a = 0; a < 2; ++a)
#pragma unroll
            for (int b = 0; b < 2; ++b)
#pragma unroll
                for (int m = 0; m < 4; ++m)
#pragma unroll
                    for (int n = 0; n < 2; ++n) acc[a][b][m][n] = (f32x4){0.f, 0.f, 0.f, 0.f};
        cur = nxt; cA = nA; cB = nB; ++ui;
        if constexpr (ALIGN_EPI) { if (wr == 1) PG8_BAR; }
    }
    PG8_WAIT_V(0);
    if constexpr (!ALIGN_EPI) { if (wr == 0) PG8_BAR; }
    PG8_BAR;
#undef PG8_SA
#undef PG8_SB
#undef PG8_STAGE
#undef PG8_LDA
#undef PG8_LDB
#undef PG8_MMA
#undef PG8_WAIT_V
#undef PG8_WAIT_L
#undef PG8_BAR
#undef PG8_SCHED
}

typedef f32x4 Acc[2][2][4][2];

struct EpiProj {
    static constexpr bool PERM = true;
    h16* P; h16* UG;
    DI void operator()(const Acc& acc, const Unit& u, int wr, int wc, int fr, int fq) const {
        const int row0 = u.pm * BM + wr * 64 + fr, col0 = u.pn * BM + wc * 32 + 8 * fq;
        const bool s5 = (u.pn == 8 || u.pn == 9);
#pragma unroll
        for (int ai = 0; ai < 2; ++ai)
#pragma unroll
            for (int m = 0; m < 4; ++m) { const int row = row0 + ai * HALF + m * 16;
#pragma unroll
                for (int bj = 0; bj < 2; ++bj) { const f32x4 v0 = acc[ai][bj][m][0], v1 = acc[ai][bj][m][1]; const int c = col0 + bj * HALF;
                    u32x4 w; w.x = pkh(v0[0], v0[1]); w.y = pkh(v0[2], v0[3]); w.z = pkh(v1[0], v1[1]); w.w = pkh(v1[2], v1[3]);
                    *(u32x4*)(P + (size_t)row * NIN + c) = w;
                    if (s5) { const int cc = c - 2048, gg = cc >> 4, ch = cc & 15, bc = row >> 5, t = row & 31;
                        *(u32x4*)(UG + ((size_t)gg * S5NC + bc) * S5K3 + t * 16 + ch) = w; } }
                asm volatile("" ::: "memory"); }
    }
};
struct EpiRes {
    static constexpr bool PERM = false;
    const float* xin; float* xout; const float* gate;
    const float* lnst; const float* lng; const float* lnb;
    DI void operator()(const Acc& acc, const Unit& u, int wr, int wc, int fr, int fq) const {
        const int row0 = u.pm * BM + wr * 64 + fr, col0 = u.pn * BM + wc * 32 + 4 * fq, b = u.pm >> 4;
        f32x4 gv[2][2], lg[2][2], lb[2][2];
#pragma unroll
        for (int bj = 0; bj < 2; ++bj)
#pragma unroll
            for (int n = 0; n < 2; ++n) { gv[bj][n] = *(const f32x4*)(gate + (size_t)b * MODW + col0 + bj * HALF + n * 16);
                if (lnst) { lg[bj][n] = *(const f32x4*)(lng + col0 + bj * HALF + n * 16) * DN_ALPHA; lb[bj][n] = *(const f32x4*)(lnb + col0 + bj * HALF + n * 16) * DN_ALPHA; }
                else { lg[bj][n] = (f32x4){DN_ALPHA, DN_ALPHA, DN_ALPHA, DN_ALPHA}; lb[bj][n] = (f32x4){0.f, 0.f, 0.f, 0.f}; } }
#pragma unroll
        for (int ai = 0; ai < 2; ++ai)
#pragma unroll
            for (int m = 0; m < 4; ++m) { const size_t row = (size_t)(row0 + ai * HALF + m * 16); const size_t off = row * DM + col0; f32x4 xv[2][2];
                const f32x2 st = lnst ? *(const f32x2*)(lnst + 2 * row) : (f32x2){0.f, 1.f};
#pragma unroll
                for (int bj = 0; bj < 2; ++bj)
#pragma unroll
                    for (int n = 0; n < 2; ++n) xv[bj][n] = *(const f32x4*)(xin + off + bj * HALF + n * 16);
#pragma unroll
                for (int bj = 0; bj < 2; ++bj)
#pragma unroll
                    for (int n = 0; n < 2; ++n) *(f32x4*)(xout + off + bj * HALF + n * 16) = ((xv[bj][n] - st.x) * st.y) * lg[bj][n] + lb[bj][n] + gv[bj][n] * acc[ai][bj][m][n];
                asm volatile("" ::: "memory"); }
    }
};
struct EpiSwiGLU {
    static constexpr bool PERM = true;
    h16* O;
    DI void operator()(const Acc& acc, const Unit& u, int wr, int wc, int fr, int fq) const {
        const int row0 = u.pm * BM + wr * 64 + fr, col0 = u.pn * HALF + wc * 32 + 8 * fq;
#pragma unroll
        for (int ai = 0; ai < 2; ++ai)
#pragma unroll
            for (int m = 0; m < 4; ++m) { float o[8];
#pragma unroll
                for (int n = 0; n < 2; ++n)
#pragma unroll
                    for (int j = 0; j < 4; ++j) o[4 * n + j] = siluf_(acc[ai][0][m][n][j]) * acc[ai][1][m][n][j];
                u32x4 w; w.x = pkh(o[0], o[1]); w.y = pkh(o[2], o[3]); w.z = pkh(o[4], o[5]); w.w = pkh(o[6], o[7]);
                *(u32x4*)(O + (size_t)(row0 + ai * HALF + m * 16) * DFF + col0) = w; asm volatile("" ::: "memory"); }
    }
};
struct EpiLR {
    static constexpr bool PERM = true;
    h16* O;
    DI void operator()(const Acc& acc, const Unit& u, int wr, int wc, int fr, int fq) const {
        const int row0 = u.pm * BM + wr * 64 + fr, col0 = u.pn * BM + wc * 32 + 8 * fq;
#pragma unroll
        for (int ai = 0; ai < 2; ++ai)
#pragma unroll
            for (int m = 0; m < 4; ++m) { const int row = row0 + ai * HALF + m * 16;
#pragma unroll
                for (int bj = 0; bj < 2; ++bj) { const f32x4 v0 = acc[ai][bj][m][0], v1 = acc[ai][bj][m][1];
                    u32x4 w; w.x = pkh(v0[0], v0[1]); w.y = pkh(v0[2], v0[3]); w.z = pkh(v1[0], v1[1]); w.w = pkh(v1[2], v1[3]);
                    *(u32x4*)(O + (size_t)row * 1536 + col0 + bj * HALF) = w; }
                asm volatile("" ::: "memory"); }
    }
};
struct EpiS5h {
    static constexpr bool PERM = false;
    float* H;
    DI void operator()(const Acc& acc, const Unit& u, int wr, int wc, int fr, int fq) const {
        const int row0 = u.pm * BM + wr * 64 + fr, col0 = wc * 32 + 4 * fq;
#pragma unroll
        for (int ai = 0; ai < 2; ++ai)
#pragma unroll
            for (int m = 0; m < 4; ++m)
#pragma unroll
                for (int n = 0; n < 2; ++n) *(f32x4*)(H + ((size_t)u.g * S5NC + row0 + ai * HALF + m * 16) * 128 + col0 + n * 16) = acc[ai][0][m][n];
    }
};
struct EpiS5y {
    static constexpr bool PERM = true;
    const h16* P; const float* dskip; h16* Y;
    DI void operator()(const Acc& acc, const Unit& u, int wr, int wc, int fr, int fq) const {
        const int row0 = u.pm * BM + wr * 64 + fr, col0 = u.pn * BM + wc * 32 + 8 * fq;
#pragma unroll
        for (int bj = 0; bj < 2; ++bj) { const int c = col0 + bj * HALF, t = c >> 4, ch = c & 15, chan = u.g * 16 + ch;
            const f32x4 d0 = *(const f32x4*)(dskip + chan), d1 = *(const f32x4*)(dskip + chan + 4);
#pragma unroll
            for (int ai = 0; ai < 2; ++ai) { half8 uv[4];
#pragma unroll
                for (int m = 0; m < 4; ++m) { const size_t tok = (size_t)(row0 + ai * HALF + m * 16) * S5L + t; uv[m] = *(const half8*)(P + tok * NIN + 2048 + chan); }
#pragma unroll
                for (int m = 0; m < 4; ++m) { const size_t tok = (size_t)(row0 + ai * HALF + m * 16) * S5L + t; float o[8];
#pragma unroll
                    for (int j2 = 0; j2 < 4; ++j2) { o[j2] = gelu_tanhf_(acc[ai][bj][m][0][j2] + d0[j2] * (float)uv[m][j2]); o[4 + j2] = gelu_tanhf_(acc[ai][bj][m][1][j2] + d1[j2] * (float)uv[m][4 + j2]); }
                    u32x4 w; w.x = pkh(o[0], o[1]); w.y = pkh(o[2], o[3]); w.z = pkh(o[4], o[5]); w.w = pkh(o[6], o[7]);
                    *(u32x4*)(Y + tok * DG + chan) = w; }
                asm volatile("" ::: "memory"); } }
    }
};
struct EpiGLU {
    static constexpr bool PERM = true;
    const h16* Y; const float* gb; h16* MIX;
    DI void operator()(const Acc& acc, const Unit& u, int wr, int wc, int fr, int fq) const {
        const int row0 = u.pm * BM + wr * 64 + fr, col0 = u.pn * BM + wc * 32 + 8 * fq;
#pragma unroll
        for (int bj = 0; bj < 2; ++bj) { const int c = col0 + bj * HALF; const f32x4 b0 = *(const f32x4*)(gb + c), b1 = *(const f32x4*)(gb + c + 4);
#pragma unroll
            for (int ai = 0; ai < 2; ++ai) { half8 yv[4];
#pragma unroll
                for (int m = 0; m < 4; ++m) yv[m] = *(const half8*)(Y + (size_t)(row0 + ai * HALF + m * 16) * DG + c);
#pragma unroll
                for (int m = 0; m < 4; ++m) { const size_t row = (size_t)(row0 + ai * HALF + m * 16); float o[8];
#pragma unroll
                    for (int j2 = 0; j2 < 4; ++j2) { o[j2] = (float)yv[m][j2] * sigmoidf_(acc[ai][bj][m][0][j2] + b0[j2]); o[4 + j2] = (float)yv[m][4 + j2] * sigmoidf_(acc[ai][bj][m][1][j2] + b1[j2]); }
                    u32x4 w; w.x = pkh(o[0], o[1]); w.y = pkh(o[2], o[3]); w.z = pkh(o[4], o[5]); w.w = pkh(o[6], o[7]);
                    *(u32x4*)(MIX + row * DM + 512 + c) = w; }
                asm volatile("" ::: "memory"); } }
    }
};
}

struct Args { const float* in[36]; float* out; unsigned char* ws; int ph_lo, ph_hi; };
enum { I_X = 0, I_C, I_ADAW, I_ADAB, I_WIN, I_WOUT, I_HGLB, I_HGNG, I_S5ARE, I_S5AIM, I_S5LDT, I_S5BRE, I_S5BIM, I_S5CRE, I_S5CIM, I_S5D, I_GLUW, I_GLUB,
       I_RWMU, I_RWW0, I_RWW2, I_RWA0, I_RWA2, I_RWG2, I_RWKK, I_RWKA, I_RWRK, I_RWGNG, I_RWGNB, I_LN1G, I_LN1B, I_FW1, I_FW3, I_FW2, I_LN2G, I_LN2B };

struct Frame {
    LAS unsigned char* lds;
    unsigned char* ws; float* out; int wave;
};
DI int opq_bid() { int b = blockIdx.x; asm volatile("" : "+s"(b)); return b; }
DI float opq_f(float c) { asm volatile("" : "+s"(c)); return c; }
#define PHASE_IDS const int lane = opq_lane(), wave = F.wave, tid = wave * 64 + lane, G = gridDim.x, bid = opq_bid(), gw = bid * NWAVES + wave, NGW = G * NWAVES; (void)lane; (void)gw; (void)NGW; (void)G; (void)bid; (void)tid;
template <class T> DI T* wsp(const Frame& F, size_t off) { unsigned o = (unsigned)off; asm volatile("" : "+s"(o)); return (T*)(F.ws + o); }
DI const float* inp(const Frame& F, int i) { (void)F; int k = i; asm volatile("" : "+s"(k));
    const __attribute__((address_space(4))) unsigned long long* t = (const __attribute__((address_space(4))) unsigned long long*)__builtin_amdgcn_kernarg_segment_ptr(); return (const float*)t[k]; }
struct TrDesc { const float* W; h16* WT; int N, ldd, w13add, k0, n0; };
DI void tr_load(const TrDesc& d, int lane, f32x4 (&v)[8]) { const int rl = lane >> 3, c4 = lane & 7;
#pragma unroll
    for (int i = 0; i < 8; ++i) v[i] = *(const f32x4*)(d.W + (size_t)(d.k0 + rl + 8 * i) * d.N + d.n0 + 4 * c4); }
DI void tr_store(const TrDesc& d, int lane, const f32x4 (&v)[8], LAS float* scr) { const int rl = lane >> 3, c4 = lane & 7;
#pragma unroll
    for (int i = 0; i < 8; ++i)
#pragma unroll
        for (int e = 0; e < 4; ++e) scr[(4 * c4 + e) * 65 + rl + 8 * i] = v[i][e];
    asm volatile("s_waitcnt lgkmcnt(0)" ::: "memory");
    const int c = lane & 7;
#pragma unroll
    for (int j = 0; j < 4; ++j) { const int n = (lane >> 3) + 8 * j; const LAS float* sp = scr + n * 65 + 8 * c; const int nn = d.n0 + n;
        const int row = d.w13add < 0 ? nn : 256 * (nn >> 7) + (nn & 127) + d.w13add;
        u32x4 o; o.x = pkh(sp[0], sp[1]); o.y = pkh(sp[2], sp[3]); o.z = pkh(sp[4], sp[5]); o.w = pkh(sp[6], sp[7]);
        *(u32x4*)(d.WT + (size_t)row * d.ldd + d.k0 + 8 * c) = o; }
    asm volatile("s_waitcnt lgkmcnt(0)" ::: "memory");
}
DI void cis_turns(double turns, float& c, float& s) { const double fr = turns - __builtin_rint(turns); const float f = (float)fr; c = __builtin_amdgcn_cosf(f); s = __builtin_amdgcn_sinf(f); }
struct S5Par { float ar, ai, dt; };
DI void s5_lampow(const S5Par& p, int tau, float& lr, float& li) {
    const float mag = __expf(p.ar * p.dt * (float)tau);
    float c, s; cis_turns((double)p.ai * (double)p.dt * (double)tau * 0.15915494309189535, c, s);
    lr = mag * c; li = mag * s;
}
DI void s5_z(const S5Par& p, float& zr, float& zi) {
    float lr, li; s5_lampow(p, 1, lr, li);
    const float rden = __builtin_amdgcn_rcpf(p.ar * p.ar + p.ai * p.ai);
    zr = ((lr - 1.f) * p.ar + li * p.ai) * rden; zi = (li * p.ar - (lr - 1.f) * p.ai) * rden;
}

DI void s5_pow_tables(const Frame& F, int l) { PHASE_IDS
    const float* are = inp(F, I_S5ARE) + l * 2048; const float* aim = inp(F, I_S5AIM) + l * 2048; const float* ldt = inp(F, I_S5LDT) + l * 32;
    const float* bre = inp(F, I_S5BRE) + (size_t)l * 32768; const float* bim = inp(F, I_S5BIM) + (size_t)l * 32768;
    float* LPW = wsp<float>(F, WS_LPW); float* BBR = wsp<float>(F, WS_BBR);
    for (int i = bid * 512 + tid; i < 2048 * 33; i += G * 512) { const int gp = i / 33, d = i - gp * 33; S5Par sp{are[gp], aim[gp], __expf(ldt[gp >> 6])}; float lr, li; s5_lampow(sp, d, lr, li); LPW[2 * i] = lr; LPW[2 * i + 1] = li; }
    for (int i = bid * 512 + tid; i < 2048 * 16; i += G * 512) { const int gp = i >> 4; S5Par sp{are[gp], aim[gp], __expf(ldt[gp >> 6])}; float zr, zi; s5_z(sp, zr, zi);
        const float br = bre[i], bi = bim[i]; BBR[2 * i] = zr * br - zi * bi; BBR[2 * i + 1] = zr * bi + zi * br; }
}
DI void convert_weights(const Frame& F, int l, int parts, int ws, int nwb, int scr_off) { PHASE_IDS
    const int gwp = bid * nwb + ws, NWP = G * nwb;
    LAS float* scr = (LAS float*)(F.lds + scr_off);
    constexpr int I_A = (DM / 64) * (NIN / 32), I_B = (DM / 64) * (DM / 32), I_C1 = (DM / 64) * (DFF / 32), I_D = (DFF / 64) * (DM / 32), I_E = (DG / 64) * (DG / 32);
    const int it_lo = (parts & 1) ? 0 : I_A, it_hi = (parts & 2) ? I_A + I_B + 2 * I_C1 + I_D + I_E : I_A;
#define TR_DESC(d, it) do { int r = (it); \
        if (r < I_A) { d.W = inp(F, I_WIN) + (size_t)l * DM * NIN; d.WT = wsp<h16>(F, WS_WIN); d.N = NIN; d.ldd = DM; d.w13add = -1; } \
        else if ((r -= I_A) < I_B) { d.W = inp(F, I_WOUT) + (size_t)l * DM * DM; d.WT = wsp<h16>(F, WS_WOUT); d.N = DM; d.ldd = DM; d.w13add = -1; } \
        else if ((r -= I_B) < I_C1) { d.W = inp(F, I_FW1) + (size_t)l * DM * DFF; d.WT = wsp<h16>(F, WS_W13); d.N = DFF; d.ldd = DM; d.w13add = 0; } \
        else if ((r -= I_C1) < I_C1) { d.W = inp(F, I_FW3) + (size_t)l * DM * DFF; d.WT = wsp<h16>(F, WS_W13); d.N = DFF; d.ldd = DM; d.w13add = 128; } \
        else if ((r -= I_C1) < I_D) { d.W = inp(F, I_FW2) + (size_t)l * DFF * DM; d.WT = wsp<h16>(F, WS_W2); d.N = DM; d.ldd = DFF; d.w13add = -1; } \
        else { r -= I_D; d.W = inp(F, I_GLUW) + (size_t)l * DG * DG; d.WT = wsp<h16>(F, WS_GLU); d.N = DG; d.ldd = DG; d.w13add = -1; } \
        const int nblk = d.N / 32; d.k0 = 64 * (r / nblk); d.n0 = 32 * (r % nblk); } while (0)
    if (parts & 3) { int it = it_lo + gwp; TrDesc dA, dB; f32x4 vA[8], vB[8];
        if (it < it_hi) { TR_DESC(dA, it); tr_load(dA, lane, vA); }
        while (it < it_hi) {
            const int it2 = it + NWP; if (it2 < it_hi) { TR_DESC(dB, it2); tr_load(dB, lane, vB); }
            tr_store(dA, lane, vA, scr);
            if (it2 >= it_hi) break;
            const int it3 = it2 + NWP; if (it3 < it_hi) { TR_DESC(dA, it3); tr_load(dA, lane, vA); }
            tr_store(dB, lane, vB, scr);
            it = it3; } }
#undef TR_DESC
    if (!(parts & 4)) return;
    const size_t gt = (size_t)gwp * 64 + lane, GT = (size_t)NWP * 64;
    { h16* LRT = wsp<h16>(F, WS_LRT); const float* w2 = inp(F, I_RWW2) + (size_t)l * 64 * DG; const float* a2 = inp(F, I_RWA2) + (size_t)l * 64 * DG; const float* g2 = inp(F, I_RWG2) + (size_t)l * 128 * DG;
        for (size_t i = gt; i < (size_t)1536 * 256; i += GT) { const int n = (int)(i >> 8), k = (int)(i & 255); float v = 0.f;
            if (n < 512) { if (k < 64) v = w2[k * DG + n]; }
            else if (n < 1024) { if (k >= 64 && k < 128) v = a2[(k - 64) * DG + (n - 512)]; }
            else { if (k >= 128) v = g2[(k - 128) * DG + (n - 1024)]; }
            LRT[i] = (h16)v; } }
    const float* cre = inp(F, I_S5CRE) + (size_t)l * 32768; const float* cim = inp(F, I_S5CIM) + (size_t)l * 32768;
    const float* LPW = wsp<float>(F, WS_LPW); const float* BBR = wsp<float>(F, WS_BBR);
    h16* T3 = wsp<h16>(F, WS_S5T3); h16* T1 = wsp<h16>(F, WS_S5T1);
    for (int un = gwp; un < 32 * 16 * 8; un += NWP) { const int g = un >> 7, c = (un >> 3) & 15, cp = 2 * (un & 7) + (lane >> 5), d = lane & 31; float kv = 0.f;
#pragma unroll 16
        for (int p = 0; p < 64; ++p) { const f32x2 lp = *(const f32x2*)(LPW + ((size_t)(g * 64 + p) * 33 + d) * 2), bb = *(const f32x2*)(BBR + ((size_t)(g * 64 + p) * 16 + cp) * 2);
            const float mr = lp.x * bb.x - lp.y * bb.y, mi = lp.x * bb.y + lp.y * bb.x;
            kv += cre[(g * 16 + c) * 64 + p] * mr - cim[(g * 16 + c) * 64 + p] * mi; }
        const h16 hv = (h16)kv;
        for (int t = 0; t < 32; ++t) { h16* rowp = T3 + ((size_t)g * 512 + t * 16 + c) * S5K3 + cp;
            if (t - d >= 0) rowp[(t - d) * 16] = hv;
            if (d > 0 && t + d < 32) rowp[(t + d) * 16] = (h16)0.f; }
    }
    for (size_t i0 = gt; i0 < (size_t)32 * 512 * 128; i0 += 4 * GT) { f32x2 lp[4]; float cr[4], ci[4];
#pragma unroll
        for (int u = 0; u < 4; ++u) { const size_t i = i0 + u * GT; const int n = (int)(i & 127), tc = (int)((i >> 7) & 511), g = (int)(i >> 16) & 31; const int t = tc >> 4, c = tc & 15, p = n & 63;
            lp[u] = *(const f32x2*)(LPW + ((size_t)(g * 64 + p) * 33 + t + 1) * 2); cr[u] = cre[(g * 16 + c) * 64 + p]; ci[u] = cim[(g * 16 + c) * 64 + p]; }
#pragma unroll
        for (int u = 0; u < 4; ++u) { const size_t i = i0 + u * GT; if (i < (size_t)32 * 512 * 128) { const int n = (int)(i & 127), tc = (int)((i >> 7) & 511), g = (int)(i >> 16);
            const float v = n < 64 ? (cr[u] * lp[u].x - ci[u] * lp[u].y) : -(cr[u] * lp[u].y + ci[u] * lp[u].x);
            T3[((size_t)g * 512 + tc) * S5K3 + 512 + n] = (h16)v; } } }
    for (size_t i0 = gt; i0 < (size_t)32 * 256 * 512; i0 += 4 * GT) { f32x2 lp[4], bb[4];
#pragma unroll
        for (int u = 0; u < 4; ++u) { const size_t i = i0 + u * GT; const int sc = (int)(i & 511), n = (int)((i >> 9) & 255), g = (int)(i >> 17) & 31; const int p = n & 63, s2 = sc >> 4, c = sc & 15;
            lp[u] = *(const f32x2*)(LPW + ((size_t)(g * 64 + p) * 33 + 31 - s2) * 2); bb[u] = *(const f32x2*)(BBR + ((size_t)(g * 64 + p) * 16 + c) * 2); }
#pragma unroll
        for (int u = 0; u < 4; ++u) { const size_t i = i0 + u * GT; if (i < (size_t)32 * 256 * 512) { const int n = (int)((i >> 9) & 255);
            const float v = n >= 128 ? 0.f : (n < 64 ? (lp[u].x * bb[u].x - lp[u].y * bb[u].y) : (lp[u].x * bb[u].y + lp[u].y * bb[u].x));
            T1[i] = (h16)v; } } }
}

DI void p0_mod(const Frame& F) { PHASE_IDS
    LAS float* cact = (LAS float*)F.lds;
    LAS float* red = (LAS float*)(F.lds + 65536);
    for (int i = tid; i < BATCH * DM; i += 512) cact[i] = siluf_(inp(F, I_C)[i]);
    __syncthreads();
    float* MOD = wsp<float>(F, WS_MOD);
    const int ks = tid >> 6, col = tid & 63;
    for (int un = bid; un < DEPTH * (MODW / 64); un += G) { const int l = un / (MODW / 64), cb = un % (MODW / 64);
        const float* w = inp(F, I_ADAW) + (size_t)l * DM * MODW + cb * 64 + col; float a[8] = {0, 0, 0, 0, 0, 0, 0, 0};
        for (int k = ks * 256; k < ks * 256 + 256; ++k) { const float wv = w[(size_t)k * MODW];
#pragma unroll
            for (int b = 0; b < 8; ++b) a[b] += cact[b * DM + k] * wv; }
#pragma unroll
        for (int b = 0; b < 8; ++b) red[(ks * 8 + b) * 64 + col] = a[b];
        __syncthreads();
        { const int b = tid >> 6; float s = 0.f;
#pragma unroll
            for (int k2 = 0; k2 < 8; ++k2) s += red[(k2 * 8 + b) * 64 + col];
            MOD[((size_t)l * BATCH + b) * MODW + cb * 64 + col] = s + inp(F, I_ADAB)[l * MODW + cb * 64 + col]; }
        __syncthreads();
    }
    if (bid == 0) { float* LB = wsp<float>(F, WS_LB); const int c = tid; const float* lg = inp(F, I_HGLB);
        const float v0 = lg[c], v1 = lg[512 + c], v2 = lg[1024 + c], v3 = lg[1536 + c]; const float mx = fmaxf(fmaxf(v0, v1), fmaxf(v2, v3));
        const float e0 = __expf(v0 - mx), e1 = __expf(v1 - mx), e2 = __expf(v2 - mx), e3 = __expf(v3 - mx), inv = __builtin_amdgcn_rcpf(e0 + e1 + e2 + e3);
        LB[c] = 0.f; LB[512 + c] = e1 * inv; LB[1024 + c] = (e1 + e2) * inv; LB[1536 + c] = (e1 + e2 + e3) * inv; }
    __syncthreads();
}
DI void modulate_rows(const Frame& F, const float* x, const float* modl, int shift_idx, h16* H) { PHASE_IDS
    for (int row = gw; row < M; row += NGW) { const int b = row >> 12; const float* sh = modl + (size_t)b * MODW + shift_idx * DM; const float* sc = sh + DM;
#pragma unroll
        for (int j = 0; j < 4; ++j) { const int c = j * 512 + lane * 8; const f32x4 x0 = *(const f32x4*)(x + (size_t)row * DM + c), x1 = *(const f32x4*)(x + (size_t)row * DM + c + 4);
            const f32x4 s0 = *(const f32x4*)(sc + c), s1 = *(const f32x4*)(sc + c + 4), h0 = *(const f32x4*)(sh + c), h1 = *(const f32x4*)(sh + c + 4);
            const f32x4 y0 = x0 * (1.f + s0) + h0, y1 = x1 * (1.f + s1) + h1;
            u32x4 w; w.x = pkh(y0[0], y0[1]); w.y = pkh(y0[2], y0[3]); w.z = pkh(y1[0], y1[1]); w.w = pkh(y1[2], y1[3]);
            *(u32x4*)(H + (size_t)row * DM + c) = w; } }
}
DI void ln_rows(const Frame& F, const float* xi, float* xo, const float* g, const float* bta, const float* modn, int shift_idx, h16* H, float* stat) { PHASE_IDS
    for (int rb = gw * 16; rb < M; rb += NGW * 16) { const int b = rb >> 12;
        f32x4 Gp[8], Bp[8];
#pragma unroll
        for (int j = 0; j < 8; ++j) { const int c = j * 256 + lane * 4; const f32x4 gv = *(const f32x4*)(g + c), bv = *(const f32x4*)(bta + c);
            if (H) { const float* sh = modn + (size_t)b * MODW + shift_idx * DM; const f32x4 sc1 = 1.f + *(const f32x4*)(sh + DM + c); Gp[j] = gv * sc1; Bp[j] = bv * sc1 + *(const f32x4*)(sh + c); }
            else { Gp[j] = gv; Bp[j] = bv; } }
        for (int r2 = 0; r2 < 16; r2 += 2) { f32x4 v[2][8];
#pragma unroll
            for (int u = 0; u < 2; ++u)
#pragma unroll
                for (int j = 0; j < 8; ++j) v[u][j] = *(const f32x4*)(xi + (size_t)(rb + r2 + u) * DM + j * 256 + lane * 4);
#pragma unroll
            for (int u = 0; u < 2; ++u) { const int row = rb + r2 + u; float s = 0.f;
#pragma unroll
                for (int j = 0; j < 8; ++j) s += (v[u][j][0] + v[u][j][1]) + (v[u][j][2] + v[u][j][3]);
                const float mean = wave_sum(s) * (1.f / DM); float q = 0.f;
#pragma unroll
                for (int j = 0; j < 8; ++j) { v[u][j] = v[u][j] - mean; q += (v[u][j][0] * v[u][j][0] + v[u][j][1] * v[u][j][1]) + (v[u][j][2] * v[u][j][2] + v[u][j][3] * v[u][j][3]); }
                const float rstd = rsqrtf_(wave_sum(q) * (1.f / DM) + opq_f(LN_EPS));
                if (stat && lane == 0) *(f32x2*)(stat + 2 * (size_t)row) = (f32x2){mean, rstd};
#pragma unroll
                for (int j = 0; j < 8; ++j) { const int c = j * 256 + lane * 4; const f32x4 y = v[u][j] * rstd * Gp[j] + Bp[j];
                    if (H) { u32x2 w; w.x = pkh(y[0], y[1]); w.y = pkh(y[2], y[3]); *(u32x2*)(H + (size_t)row * DM + c) = w; }
                    else *(f32x4*)(xo + (size_t)row * DM + c) = y; } } }
    }
}

DI void prep_rows(const Frame& F, int l) { PHASE_IDS
    const h16* P = wsp<h16>(F, WS_PROJ); h16* RWA = wsp<h16>(F, WS_RWA);
    const float* mu = inp(F, I_RWMU) + l * 1792;
    float mu4[4];
#pragma unroll
    for (int j = 0; j < 4; ++j) mu4[j] = mu[1536 + 4 * lane + j];
    for (int row0 = gw; row0 < M; row0 += 4 * NGW) { half4 cur[4], prv[4];
#pragma unroll
        for (int u = 0; u < 4; ++u) { const int row = row0 + u * NGW; const int rowc = row < M ? row : M - 1; const int t = rowc & (SEQ - 1); const h16* pr = P + (size_t)rowc * NIN;
            cur[u] = *(const half4*)(pr + RWOFF + 1536 + 4 * lane); prv[u] = *(const half4*)(pr - (t > 0 ? NIN : 0) + RWOFF + 1536 + 4 * lane); if (t == 0) prv[u] = (half4){0, 0, 0, 0}; }
#pragma unroll
        for (int u = 0; u < 4; ++u) { const int row = row0 + u * NGW; if (row < M) { float o[4];
#pragma unroll
            for (int j = 0; j < 4; ++j) { const float cv = (float)cur[u][j], sv = cv + mu4[j] * ((float)prv[u][j] - cv); o[j] = lane < 16 ? tanhf_(sv) : (lane < 32 ? sv : sigmoidf_(sv)); }
            u32x2 w; w.x = pkh(o[0], o[1]); w.y = pkh(o[2], o[3]); *(u32x2*)(RWA + (size_t)row * 256 + 4 * lane) = w; } }
    }
}
constexpr int RR_KH = 0, RR_RH = 2304, RR_BT = 4608, RR_KT = 6656, RR_VV = 8704, RR_TT = 10752, RR_A3 = 11264, RR_A2 = 11776, RR_A4 = 12288, RR_GL = 12800, RR_BYTES = 13312, RR_P = 72;
DI float wave_sum_all(float v) { v = sum16(v);
    const int iv = __builtin_bit_cast(int, v);
    return (__builtin_bit_cast(float, __builtin_amdgcn_readlane(iv, 0)) + __builtin_bit_cast(float, __builtin_amdgcn_readlane(iv, 16))) + (__builtin_bit_cast(float, __builtin_amdgcn_readlane(iv, 32)) + __builtin_bit_cast(float, __builtin_amdgcn_readlane(iv, 48))); }
DI void rwkv_chunk_prep(const Frame& F, int l) { PHASE_IDS
    const h16* P = wsp<h16>(F, WS_PROJ); const h16* LR = wsp<h16>(F, WS_LR16); unsigned char* REC = wsp<unsigned char>(F, WS_RWREC); float* BON = wsp<float>(F, WS_RWBON);
    LAS unsigned short* L = (LAS unsigned short*)(F.lds + wave * 16384);
    LAS float* A1L = (LAS float*)(F.lds + wave * 16384 + 4 * 16 * RR_P * 2);
    const float* mu = inp(F, I_RWMU) + l * 1792;
    const int k = lane, rr = lane & 15, q = lane >> 4;
    const int kperm = (k & 32) + 8 * ((k >> 2) & 3) + 4 * ((k >> 4) & 1) + (k & 3);
    int hprev = -1; float mur = 0.f, muk = 0.f, muv = 0.f, kk_ = 0.f, ka_ = 0.f, rk_ = 0.f, w0_ = 0.f, a0_ = 0.f;
    for (int cu = gw; cu < BATCH * 8 * 256; cu += NGW) { const int c = cu & 255, bh = cu >> 8, b = bh >> 3, h = bh & 7, col = h * 64 + k;
        const size_t t0 = (size_t)b * SEQ + 16 * c; unsigned char* rec = REC + (size_t)cu * RR_BYTES;
        if (h != hprev) { hprev = h;
            mur = mu[col]; muk = mu[512 + col]; muv = mu[1024 + col]; kk_ = inp(F, I_RWKK)[l * DG + col]; ka_ = inp(F, I_RWKA)[l * DG + col]; rk_ = inp(F, I_RWRK)[l * DG + col];
            w0_ = inp(F, I_RWW0)[l * DG + col]; a0_ = inp(F, I_RWA0)[l * DG + col]; }
        float rp = 0.f, kp_ = 0.f, vp = 0.f;
        if (c > 0) { const h16* pp = P + (t0 - 1) * NIN + RWOFF + col; rp = (float)pp[0]; kp_ = (float)pp[512]; vp = (float)pp[1024]; }
        float G = 1.f, bcv[16], kcv[16];
        h16 rin[16], kin[16], vin[16], zwin[16], zain[16];
#pragma unroll
        for (int jj = 0; jj < 16; ++jj) { const h16* pr = P + (t0 + jj) * NIN + RWOFF + col; rin[jj] = pr[0]; kin[jj] = pr[512]; vin[jj] = pr[1024]; zwin[jj] = LR[(t0 + jj) * 1536 + col]; zain[jj] = LR[(t0 + jj) * 1536 + 512 + col]; }
#pragma unroll
        for (int jj = 0; jj < 16; ++jj) { const float rc = (float)rin[jj], kc = (float)kin[jj], vc = (float)vin[jj];
            const float r = rc + mur * (rp - rc), kx = kc + muk * (kp_ - kc), vx = vc + muv * (vp - vc); rp = rc; kp_ = kc; vp = vc;
            const float a = sigmoidf_((float)zain[jj] + a0_), wd = __expf(-0.6065306597126334f * sigmoidf_((float)zwin[jj] + w0_));
            const float kkr = kx * kk_; const float n2 = wave_sum_all(kkr * kkr); const float kap = kkr * rsqrtf_(fmaxf(n2, 1e-24f));
            const float kpr = kx * (1.f + (a - 1.f) * ka_); const float bs = wave_sum_all(r * kpr * rk_);
            if (lane == 0) BON[(t0 + jj) * 8 + h] = bs;
            const float Gm = G; G *= wd; const float rg = __builtin_amdgcn_rcpf(G);
            const unsigned short khb = f2bf(kap * Gm), rhb = f2bf(r * G); bcv[jj] = kap * a * rg; kcv[jj] = kpr * rg;
            *(unsigned short*)(rec + RR_KH + (jj * RR_P + kperm) * 2) = khb; *(unsigned short*)(rec + RR_RH + (jj * RR_P + kperm) * 2) = rhb;
            *(unsigned short*)(rec + RR_VV + (jj * 64 + k) * 2) = f2bf(vx);
            L[jj * RR_P + k] = khb; L[(16 + jj) * RR_P + k] = rhb; L[(32 + jj) * RR_P + k] = f2bf(bcv[jj]); L[(48 + jj) * RR_P + k] = f2bf(kcv[jj]); }
        { u32x4 b0, b1, k0, k1;
#define PK2(x, y) ((unsigned)f2bf(x) | ((unsigned)f2bf(y) << 16))
            b0.x = PK2(-bcv[0], -bcv[1]); b0.y = PK2(-bcv[2], -bcv[3]); b0.z = PK2(-bcv[4], -bcv[5]); b0.w = PK2(-bcv[6], -bcv[7]); b1.x = PK2(-bcv[8], -bcv[9]); b1.y = PK2(-bcv[10], -bcv[11]); b1.z = PK2(-bcv[12], -bcv[13]); b1.w = PK2(-bcv[14], -bcv[15]);
            k0.x = PK2(kcv[0], kcv[1]); k0.y = PK2(kcv[2], kcv[3]); k0.z = PK2(kcv[4], kcv[5]); k0.w = PK2(kcv[6], kcv[7]); k1.x = PK2(kcv[8], kcv[9]); k1.y = PK2(kcv[10], kcv[11]); k1.z = PK2(kcv[12], kcv[13]); k1.w = PK2(kcv[14], kcv[15]);
            *(u32x4*)(rec + RR_BT + k * 32) = b0; *(u32x4*)(rec + RR_BT + k * 32 + 16) = b1; *(u32x4*)(rec + RR_KT + k * 32) = k0; *(u32x4*)(rec + RR_KT + k * 32 + 16) = k1;
            *(float*)(rec + RR_GL + k * 4) = G; }
        asm volatile("s_waitcnt lgkmcnt(0)" ::: "memory");
        f32x4 A1 = {0.f, 0.f, 0.f, 0.f}, A2 = A1, A3 = A1, A4 = A1;
#pragma unroll
        for (int ks = 0; ks < 2; ++ks) { const int off = rr * RR_P + 32 * ks + 8 * q;
            const bf16x8 fkh = *(const LAS bf16x8*)(L + off), frh = *(const LAS bf16x8*)(L + 16 * RR_P + off), fbc = *(const LAS bf16x8*)(L + 32 * RR_P + off), fkc = *(const LAS bf16x8*)(L + 48 * RR_P + off);
            A1 = __builtin_amdgcn_mfma_f32_16x16x32_bf16(fbc, fkh, A1, 0, 0, 0); A2 = __builtin_amdgcn_mfma_f32_16x16x32_bf16(fkc, fkh, A2, 0, 0, 0);
            A3 = __builtin_amdgcn_mfma_f32_16x16x32_bf16(fbc, frh, A3, 0, 0, 0); A4 = __builtin_amdgcn_mfma_f32_16x16x32_bf16(fkc, frh, A4, 0, 0, 0); }
        { u32x2 w3, w2, w4; float m3[4], m2[4], m4[4];
#pragma unroll
            for (int i2 = 0; i2 < 4; ++i2) { const int sidx = 4 * q + i2; const bool lt = sidx < rr, le = sidx <= rr;
                A1L[sidx * 16 + rr] = lt ? A1[i2] : 0.f; m2[i2] = lt ? A2[i2] : 0.f; m3[i2] = le ? -A3[i2] : 0.f; m4[i2] = le ? A4[i2] : 0.f; }
            w3.x = PK2(m3[0], m3[1]); w3.y = PK2(m3[2], m3[3]); w2.x = PK2(m2[0], m2[1]); w2.y = PK2(m2[2], m2[3]); w4.x = PK2(m4[0], m4[1]); w4.y = PK2(m4[2], m4[3]);
            *(u32x2*)(rec + RR_A3 + (rr * 16 + 4 * q) * 2) = w3; *(u32x2*)(rec + RR_A2 + (rr * 16 + 4 * q) * 2) = w2; *(u32x2*)(rec + RR_A4 + (rr * 16 + 4 * q) * 2) = w4; }
        asm volatile("s_waitcnt lgkmcnt(0)" ::: "memory");
        { float x[16];
#pragma unroll
            for (int sidx = 15; sidx >= 0; --sidx) { float acc = (sidx == rr) ? 1.f : 0.f;
#pragma unroll
                for (int s2 = sidx + 1; s2 < 16; ++s2) acc -= A1L[sidx * 16 + s2] * x[s2];
                x[sidx] = acc; }
            if (lane < 16) { u32x4 t0v, t1v; t0v.x = PK2(x[0], x[1]); t0v.y = PK2(x[2], x[3]); t0v.z = PK2(x[4], x[5]); t0v.w = PK2(x[6], x[7]); t1v.x = PK2(x[8], x[9]); t1v.y = PK2(x[10], x[11]); t1v.z = PK2(x[12], x[13]); t1v.w = PK2(x[14], x[15]);
                *(u32x4*)(rec + RR_TT + lane * 32) = t0v; *(u32x4*)(rec + RR_TT + lane * 32 + 16) = t1v; } }
#undef PK2
        asm volatile("s_waitcnt lgkmcnt(0)" ::: "memory");
    }
}
DI void s5_chunk_scan(const Frame& F, int l) { PHASE_IDS
    const float* HL = wsp<float>(F, WS_HLOC); h16* UG = wsp<h16>(F, WS_UG);
    const float* are = inp(F, I_S5ARE) + l * 2048; const float* aim = inp(F, I_S5AIM) + l * 2048; const float* ldt = inp(F, I_S5LDT) + l * 32;
    for (int un = gw; un < 32 * BATCH; un += NGW) { const int g = un >> 3, b = un & 7, p = lane;
        S5Par sp{are[g * 64 + p], aim[g * 64 + p], __expf(ldt[g])}; float Lr, Li; s5_lampow(sp, S5L, Lr, Li);
        float hr = 0.f, hi = 0.f; const size_t base = (size_t)g * S5NC + b * 128;
        for (int c0 = 0; c0 < 128; c0 += 32) { float xr[32], xi[32];
#pragma unroll
            for (int j = 0; j < 32; ++j) { xr[j] = HL[(base + c0 + j) * 128 + p]; xi[j] = HL[(base + c0 + j) * 128 + 64 + p]; }
#pragma unroll
            for (int j = 0; j < 32; ++j) { h16* dst = UG + (base + c0 + j) * S5K3 + 512; dst[p] = (h16)hr; dst[64 + p] = (h16)hi;
                const float nr = Lr * hr - Li * hi + xr[j], ni = Lr * hi + Li * hr + xi[j]; hr = nr; hi = ni; } }
    }
}

typedef float f32x16 __attribute__((ext_vector_type(16)));
DI void attention_units(const Frame& F, int ws, int nwb) { PHASE_IDS
    const int NWP = G * nwb, gwp = NWP - 1 - (bid * nwb + ws);
    const h16* P = wsp<h16>(F, WS_PROJ); h16* MIX = wsp<h16>(F, WS_H16);
    const int r = lane & 31, hh = lane >> 5;
    for (int un = gwp; un < BATCH * 4 * (SEQ / 32); un += NWP) { const int qt = un & 127, bh = un >> 7, b = bh >> 2, h = bh & 3, t0 = 32 * qt;
        const size_t tokb = (size_t)b * SEQ;
        half8 qf[8];
#pragma unroll
        for (int s8 = 0; s8 < 8; ++s8) qf[s8] = *(const half8*)(P + (tokb + t0 + r) * NIN + 2560 + h * 128 + 16 * s8 + 8 * hh);
        f32x16 oacc[4];
#pragma unroll
        for (int mt = 0; mt < 4; ++mt)
#pragma unroll
            for (int i2 = 0; i2 < 16; ++i2) oacc[mt][i2] = 0.f;
        float run = 0.f;
        for (int k0 = t0; k0 >= 0; k0 -= 32) {
            f32x16 sacc;
#pragma unroll
            for (int i2 = 0; i2 < 16; ++i2) sacc[i2] = 0.f;
            const h16* kr = P + (tokb + k0 + r) * NIN + 3072 + h * 128 + 8 * hh; const h16* vr = P + (tokb + k0 + 4 * hh) * NIN + 3584 + h * 128 + 4 * r;
            half8 kfa[8]; half4 vqa[16];
#pragma unroll
            for (int s8 = 0; s8 < 8; ++s8) kfa[s8] = *(const half8*)(kr + 16 * s8);
#pragma unroll
            for (int jj = 0; jj < 16; ++jj) vqa[jj] = *(const half4*)(vr + (size_t)(16 * (jj >> 3) + 8 * ((jj >> 2) & 1) + (jj & 3)) * NIN);
            __builtin_amdgcn_sched_barrier(0);
#pragma unroll
            for (int s8 = 0; s8 < 8; ++s8) sacc = __builtin_amdgcn_mfma_f32_32x32x16_f16(kfa[s8], qf[s8], sacc, 0, 0, 0);
            const bool diag = (k0 == t0);
            float ls[16], zz[16];
#pragma unroll
            for (int i2 = 0; i2 < 16; ++i2) { const int kc = (i2 & 3) + 8 * (i2 >> 2) + 4 * hh; const bool valid = !diag || (kc < r);
                zz[i2] = sacc[i2] * 0.08838834764831845f; ls[i2] = valid ? -softplusf_(zz[i2]) : 0.f; }
            float Gs[4], Ps[4];
#pragma unroll
            for (int g = 0; g < 4; ++g) { Gs[g] = (ls[4 * g] + ls[4 * g + 1]) + (ls[4 * g + 2] + ls[4 * g + 3]); Ps[g] = __shfl_xor(Gs[g], 32); }
            float later = 0.f, T[4];
#pragma unroll
            for (int g = 3; g >= 0; --g) { T[g] = later + (hh == 0 ? Ps[g] : 0.f); later += Gs[g] + Ps[g]; }
            half8 wf[2];
#pragma unroll
            for (int g = 0; g < 4; ++g) { float af[4]; af[3] = run + T[g]; af[2] = af[3] + ls[4 * g + 3]; af[1] = af[2] + ls[4 * g + 2]; af[0] = af[1] + ls[4 * g + 1];
#pragma unroll
                for (int e = 0; e < 4; ++e) { const int i2 = 4 * g + e; const int kc = (i2 & 3) + 8 * (i2 >> 2) + 4 * hh; const bool valid = !diag || (kc < r);
                    const float w = valid ? __expf(zz[i2] + ls[i2] + af[e]) : 0.f; wf[g >> 1][4 * (g & 1) + e] = (h16)w; } }
            run += later;
#pragma unroll
            for (int s2 = 0; s2 < 2; ++s2) { half8 vf[4];
#pragma unroll
                for (int jj = 0; jj < 8; ++jj) { const half4 v4 = vqa[8 * s2 + jj]; vf[0][jj] = v4[0]; vf[1][jj] = v4[1]; vf[2][jj] = v4[2]; vf[3][jj] = v4[3]; }
#pragma unroll
                for (int mt = 0; mt < 4; ++mt) oacc[mt] = __builtin_amdgcn_mfma_f32_32x32x16_f16(vf[mt], wf[s2], oacc[mt], 0, 0, 0); }
            if (__builtin_amdgcn_ballot_w64(run >= -110.f) == 0ull) break;
        }
        h16* orow = MIX + (tokb + t0 + r) * DM + 1024 + h * 128;
#pragma unroll
        for (int i2 = 0; i2 < 16; ++i2) { const int m = (i2 & 3) + 8 * (i2 >> 2) + 4 * hh; u32x2 w; w.x = pkh(oacc[0][i2], oacc[1][i2]); w.y = pkh(oacc[2][i2], oacc[3][i2]);
            *(u32x2*)(orow + 4 * m) = w; }
    }
}

typedef __bf16 bfv4 __attribute__((ext_vector_type(4)));
DI bf16x4 pack4bf(const f32x4 v) { return __builtin_bit_cast(bf16x4, __builtin_convertvector(v, bfv4)); }
DI bf16x8 cat8(const bf16x4 a, const bf16x4 b) { bf16x8 r; r[0] = a[0]; r[1] = a[1]; r[2] = a[2]; r[3] = a[3]; r[4] = b[0]; r[5] = b[1]; r[6] = b[2]; r[7] = b[3]; return r; }
constexpr int RW_NSLOT = 9, RW_SYNC_OFF = MISC_OFF + 128;
DI void rwkv_sync_zero(const Frame& F) { volatile LAS unsigned* sy = (volatile LAS unsigned*)(F.lds + RW_SYNC_OFF); if (F.wave == 0 && opq_lane() == 0) { sy[0] = 0u; sy[1] = 0u; sy[2] = 0u; } }
DI void rwkv_scan_loader(const Frame& F, int w) { PHASE_IDS
    volatile LAS unsigned* sy = (volatile LAS unsigned*)(F.lds + RW_SYNC_OFF);
    const unsigned ring = (unsigned)(size_t)F.lds;
    int ui = 0;
    for (int un = bid; un < 256; un += G, ++ui) { const int bh = un >> 2;
        const unsigned char* REC = wsp<unsigned char>(F, WS_RWREC) + (size_t)bh * 256 * RR_BYTES;
        for (int i2 = 0; i2 < 128; ++i2) { const int c = 2 * i2 + w, gc = ui * 256 + c;
            for (unsigned sp = 0; (int)(gc - (int)sy[2]) >= RW_NSLOT && sp < (1u << 22); ++sp) __builtin_amdgcn_s_sleep(2);
            const char* src = (const char*)(REC + (size_t)c * RR_BYTES); const unsigned dst = ring + (unsigned)((gc % RW_NSLOT) * RR_BYTES);
#pragma unroll
            for (int p = 0; p < 13; ++p) pg8::glds16_s(src + p * 1024, (unsigned)lane * 16u, dst + p * 1024u);
            if (i2 >= 3) { asm volatile("s_waitcnt vmcnt(39)" ::: "memory"); if (lane == 0) sy[w] = (unsigned)(ui * 128 + i2 - 2); }
        }
        asm volatile("s_waitcnt vmcnt(0)" ::: "memory"); if (lane == 0) sy[w] = (unsigned)(ui * 128 + 128);
    }
}
DI void rwkv_scan_consumer(const Frame& F) { PHASE_IDS
    volatile LAS unsigned* sy = (volatile LAS unsigned*)(F.lds + RW_SYNC_OFF);
    const int rr = lane & 15, q = lane >> 4; const int q1 = q & 1; const bool qlo = q < 2;
    const bf16x4 z4 = {0, 0, 0, 0}; const bf16x8 z8 = {0, 0, 0, 0, 0, 0, 0, 0};
    int ui = 0;
    for (int un = bid; un < 256; un += G, ++ui) { const int vq = un & 3, bh = un >> 2, b = bh >> 3, h = bh & 7;
        __attribute__((address_space(1))) h16* RAW = (__attribute__((address_space(1))) h16*)(wsp<h16>(F, WS_RWRAW) + (size_t)b * SEQ * DG + h * 64 + 16 * vq + rr);
        f32x4 ST[4];
#pragma unroll
        for (int kt = 0; kt < 4; ++kt) ST[kt] = (f32x4){0.f, 0.f, 0.f, 0.f};
        for (int c = 0; c < 256; ++c) { const int gc = ui * 256 + c; const unsigned need = (unsigned)(ui * 128 + (c >> 1) + 1);
            for (unsigned sp = 0; sy[c & 1] < need && sp < (1u << 22); ++sp) __builtin_amdgcn_s_sleep(1);
            const LAS unsigned char* sl = F.lds + (gc % RW_NSLOT) * RR_BYTES;
            bf16x8 khf[2], rhf[2], ktf[4], a2f, a4f, ttf, a3f, btf[4], vB; f32x4 gl[4];
#pragma unroll
            for (int ks = 0; ks < 2; ++ks) { khf[ks] = *(const LAS bf16x8*)(sl + RR_KH + (rr * RR_P + 32 * ks + 8 * q) * 2); rhf[ks] = *(const LAS bf16x8*)(sl + RR_RH + (rr * RR_P + 32 * ks + 8 * q) * 2); }
            a2f = *(const LAS bf16x8*)(sl + RR_A2 + (rr * 16 + 8 * q1) * 2); a4f = *(const LAS bf16x8*)(sl + RR_A4 + (rr * 16 + 8 * q1) * 2);
            ttf = cat8(*(const LAS bf16x4*)(sl + RR_TT + (rr * 16 + 4 * q) * 2), z4); a3f = cat8(*(const LAS bf16x4*)(sl + RR_A3 + (rr * 16 + 4 * q) * 2), z4);
#pragma unroll
            for (int kt = 0; kt < 4; ++kt) { btf[kt] = cat8(*(const LAS bf16x4*)(sl + RR_BT + ((16 * kt + rr) * 16 + 4 * q) * 2), z4);
                ktf[kt] = *(const LAS bf16x8*)(sl + RR_KT + ((16 * kt + rr) * 16 + 8 * q1) * 2); gl[kt] = *(const LAS f32x4*)(sl + RR_GL + (16 * kt + 4 * q) * 4); }
#pragma unroll
            for (int jj = 0; jj < 8; ++jj) vB[jj] = *(const LAS short*)(sl + RR_VV + ((8 * q1 + jj) * 64 + 16 * vq + rr) * 2);
            asm volatile("s_waitcnt lgkmcnt(0)" ::: "memory");
            __builtin_amdgcn_sched_barrier(0);
            if (lane == 0) sy[2] = (unsigned)(gc + 1);
            a2f = qlo ? a2f : z8; a4f = qlo ? a4f : z8; vB = qlo ? vB : z8;
#pragma unroll
            for (int kt = 0; kt < 4; ++kt) ktf[kt] = qlo ? ktf[kt] : z8;
            const bf16x8 sb0 = cat8(pack4bf(ST[0]), pack4bf(ST[1])), sb1 = cat8(pack4bf(ST[2]), pack4bf(ST[3]));
            f32x4 acc = {0.f, 0.f, 0.f, 0.f};
            acc = __builtin_amdgcn_mfma_f32_16x16x32_bf16(a2f, vB, acc, 0, 0, 0); acc = __builtin_amdgcn_mfma_f32_16x16x32_bf16(khf[0], sb0, acc, 0, 0, 0); acc = __builtin_amdgcn_mfma_f32_16x16x32_bf16(khf[1], sb1, acc, 0, 0, 0);
            const bf16x8 rB = cat8(pack4bf(acc), z4);
            f32x4 e = {0.f, 0.f, 0.f, 0.f}; e = __builtin_amdgcn_mfma_f32_16x16x32_bf16(ttf, rB, e, 0, 0, 0);
            const bf16x8 eB = cat8(pack4bf(e), z4);
            f32x4 o = {0.f, 0.f, 0.f, 0.f};
            o = __builtin_amdgcn_mfma_f32_16x16x32_bf16(a4f, vB, o, 0, 0, 0); o = __builtin_amdgcn_mfma_f32_16x16x32_bf16(rhf[0], sb0, o, 0, 0, 0); o = __builtin_amdgcn_mfma_f32_16x16x32_bf16(rhf[1], sb1, o, 0, 0, 0);
            o = __builtin_amdgcn_mfma_f32_16x16x32_bf16(a3f, eB, o, 0, 0, 0);
#pragma unroll
            for (int kt = 0; kt < 4; ++kt) { f32x4 t = __builtin_amdgcn_mfma_f32_16x16x32_bf16(btf[kt], eB, ST[kt], 0, 0, 0); t = __builtin_amdgcn_mfma_f32_16x16x32_bf16(ktf[kt], vB, t, 0, 0, 0); ST[kt] = t * gl[kt]; }
#pragma unroll
            for (int i2 = 0; i2 < 4; ++i2) RAW[(size_t)(16 * c + 4 * q + i2) * DG] = (h16)o[i2];
        }
    }
}
DI void hgrn_prep(const Frame& F, int l) { PHASE_IDS
    const h16* P = wsp<h16>(F, WS_PROJ); unsigned short* KT = wsp<unsigned short>(F, WS_HGK); unsigned short* QT = wsp<unsigned short>(F, WS_HGQ); float* HB = wsp<float>(F, WS_HGB);
    const float lbc = 1.f - wsp<float>(F, WS_LB)[l * 512 + tid];
    for (int un = bid; un < BATCH * 64; un += G) { const size_t tok0 = (size_t)un * 64;
        float B = 0.f, Bmid = 0.f;
        for (int th = 0; th < 64; th += 32) { h16 zin[32];
#pragma unroll
            for (int t = 0; t < 32; ++t) zin[t] = P[(tok0 + th + t) * NIN + 512 + tid];
#pragma unroll
            for (int t = 0; t < 32; ++t) { const float k = lbc * sigmoidf_(-(float)zin[t]); B += 0.6931471805599453f * __builtin_amdgcn_logf(1.f - k); if (th + t == 31) Bmid = B; } }
        HB[(size_t)un * 1024 + tid] = Bmid; HB[(size_t)un * 1024 + 512 + tid] = B;
        B = 0.f;
        for (int th = 0; th < 64; th += 32) { h16 zin[32], qin[32];
#pragma unroll
            for (int t = 0; t < 32; ++t) { zin[t] = P[(tok0 + th + t) * NIN + 512 + tid]; qin[t] = P[(tok0 + th + t) * NIN + tid]; }
#pragma unroll
            for (int t = 0; t < 32; ++t) { const float z = (float)zin[t], qv = (float)qin[t]; const float k = lbc * sigmoidf_(-z);
                B += 0.6931471805599453f * __builtin_amdgcn_logf(1.f - k);
                QT[(tok0 + th + t) * DG + tid] = f2bf(siluf_(qv) * __expf(fminf(B - Bmid, 80.f))); KT[(tok0 + th + t) * DG + tid] = f2bf(k * __expf(fminf(Bmid - B, 80.f))); } }
    }
}
DI void hgrn_loc_units(const Frame& F) { PHASE_IDS
    const h16* P = wsp<h16>(F, WS_PROJ); const unsigned short* KT = wsp<unsigned short>(F, WS_HGK); unsigned short* ST = wsp<unsigned short>(F, WS_HGST); const float* HB = wsp<float>(F, WS_HGB);
    const int r = lane & 31, hh = lane >> 5;
    for (int un = gw; un < BATCH * 4 * 64 * 4; un += NGW) { const int mt = un & 3, bhc = un >> 2, c = bhc & 63, bh = bhc >> 6, b = bh >> 2, h = bh & 3;
        const size_t tok0 = ((size_t)b * 64 + c) * 64;
        f32x16 acc[4];
#pragma unroll
        for (int nt = 0; nt < 4; ++nt)
#pragma unroll
            for (int i2 = 0; i2 < 16; ++i2) acc[nt][i2] = 0.f;
        bf16x8 afa[4], bfa[4][4];
#pragma unroll
        for (int s4 = 0; s4 < 4; ++s4)
#pragma unroll
            for (int jj = 0; jj < 8; ++jj) { const size_t tk = tok0 + 16 * s4 + 8 * hh + jj;
                afa[s4][jj] = (short)f2bf((float)P[tk * NIN + 1024 + h * 128 + 4 * r + mt]);
                const bf16x4 k4 = *(const bf16x4*)(KT + tk * DG + h * 128 + 4 * r); bfa[s4][0][jj] = k4[0]; bfa[s4][1][jj] = k4[1]; bfa[s4][2][jj] = k4[2]; bfa[s4][3][jj] = k4[3]; }
        const float* hb = HB + ((size_t)b * 64 + c) * 1024 + h * 128 + 4 * r; const f32x4 bm = *(const f32x4*)hb, bl = *(const f32x4*)(hb + 512);
        __builtin_amdgcn_sched_barrier(0);
#pragma unroll
        for (int s4 = 0; s4 < 4; ++s4)
#pragma unroll
            for (int nt = 0; nt < 4; ++nt) acc[nt] = __builtin_amdgcn_mfma_f32_32x32x16_bf16(afa[s4], bfa[s4][nt], acc[nt], 0, 0, 0);
        float e[4];
#pragma unroll
        for (int nt = 0; nt < 4; ++nt) e[nt] = __expf(bl[nt] - bm[nt]);
        unsigned short* st = ST + (size_t)bhc * 16384 + 4 * r;
#pragma unroll
        for (int i2 = 0; i2 < 16; ++i2) { const int v = 4 * ((i2 & 3) + 8 * (i2 >> 2) + 4 * hh) + mt;
            u32x2 w; w.x = (unsigned)f2bf(acc[0][i2] * e[0]) | ((unsigned)f2bf(acc[1][i2] * e[1]) << 16); w.y = (unsigned)f2bf(acc[2][i2] * e[2]) | ((unsigned)f2bf(acc[3][i2] * e[3]) << 16);
            *(u32x2*)(st + (size_t)v * 128) = w; }
    }
}
DI void hgrn_state_scan(const Frame& F) { PHASE_IDS
    unsigned short* ST = wsp<unsigned short>(F, WS_HGST); const float* HB = wsp<float>(F, WS_HGB);
    for (int e0 = bid * 512 + tid; e0 < 32 * 4096; e0 += G * 512) { const int bh = e0 >> 12, rem = e0 & 4095, v = rem >> 5, k4 = (rem & 31) * 4, b = bh >> 2, h = bh & 3;
        float s0 = 0.f, s1 = 0.f, s2 = 0.f, s3 = 0.f;
        unsigned short* st = ST + (size_t)bh * 64 * 16384 + (size_t)v * 128 + k4; const float* hb = HB + (size_t)b * 64 * 1024 + h * 128 + k4;
        for (int c0 = 0; c0 < 64; c0 += 8) { u32x2 wv[8]; f32x4 bmv[8], blv[8];
#pragma unroll
            for (int j = 0; j < 8; ++j) { wv[j] = *(const u32x2*)(st + (size_t)(c0 + j) * 16384); bmv[j] = *(const f32x4*)(hb + (size_t)(c0 + j) * 1024); blv[j] = *(const f32x4*)(hb + (size_t)(c0 + j) * 1024 + 512); }
#pragma unroll
            for (int j = 0; j < 8; ++j) { const u32x2 w = wv[j]; const f32x4 bm = bmv[j], bl = blv[j];
                u32x2 o; o.x = (unsigned)f2bf(s0 * __expf(bm[0])) | ((unsigned)f2bf(s1 * __expf(bm[1])) << 16); o.y = (unsigned)f2bf(s2 * __expf(bm[2])) | ((unsigned)f2bf(s3 * __expf(bm[3])) << 16);
                *(u32x2*)(st + (size_t)(c0 + j) * 16384) = o;
                s0 = s0 * __expf(bl[0]) + bf2f((unsigned short)(w.x & 0xffffu)); s1 = s1 * __expf(bl[1]) + bf2f((unsigned short)(w.x >> 16));
                s2 = s2 * __expf(bl[2]) + bf2f((unsigned short)(w.y & 0xffffu)); s3 = s3 * __expf(bl[3]) + bf2f((unsigned short)(w.y >> 16)); } }
    }
}
DI void hgrn_out_unit(const Frame& F, int un, const float* ng) { PHASE_IDS
    const h16* P = wsp<h16>(F, WS_PROJ); const unsigned short* KT = wsp<unsigned short>(F, WS_HGK); const unsigned short* QT = wsp<unsigned short>(F, WS_HGQ);
    const unsigned short* ST = wsp<unsigned short>(F, WS_HGST); h16* MIX = wsp<h16>(F, WS_H16);
    const int r = lane & 31, hh = lane >> 5;
    const int tt = un & 1, bhc = un >> 1, c = bhc & 63, bh = bhc >> 6, b = bh >> 2, h = bh & 3;
    const size_t tok0 = ((size_t)b * 64 + c) * 64, tq = tok0 + 32 * tt + r;
    bf16x8 qf[8];
#pragma unroll
    for (int s8 = 0; s8 < 8; ++s8) qf[s8] = *(const bf16x8*)(QT + tq * DG + h * 128 + 16 * s8 + 8 * hh);
    f32x16 oacc[4];
#pragma unroll
    for (int mt = 0; mt < 4; ++mt)
#pragma unroll
        for (int i2 = 0; i2 < 16; ++i2) oacc[mt][i2] = 0.f;
    const unsigned short* st = ST + (size_t)bhc * 16384 + (size_t)(4 * r) * 128 + 8 * hh;
#pragma unroll
    for (int s8h = 0; s8h < 8; s8h += 4) { bf16x8 sfa[4][4];
#pragma unroll
        for (int s8 = 0; s8 < 4; ++s8)
#pragma unroll
            for (int mt = 0; mt < 4; ++mt) sfa[s8][mt] = *(const bf16x8*)(st + mt * 128 + 16 * (s8h + s8));
        __builtin_amdgcn_sched_barrier(0);
#pragma unroll
        for (int s8 = 0; s8 < 4; ++s8)
#pragma unroll
            for (int mt = 0; mt < 4; ++mt) oacc[mt] = __builtin_amdgcn_mfma_f32_32x32x16_bf16(sfa[s8][mt], qf[s8h + s8], oacc[mt], 0, 0, 0); }
    for (int st2 = 0; st2 <= tt; ++st2) { f32x16 sacc;
#pragma unroll
        for (int i2 = 0; i2 < 16; ++i2) sacc[i2] = 0.f;
        const unsigned short* kr = KT + (tok0 + 32 * st2 + r) * DG + h * 128 + 8 * hh; const h16* vr = P + (tok0 + 32 * st2 + 4 * hh) * NIN + 1024 + h * 128 + 4 * r;
        bf16x8 kfa[8]; half4 vqa[16];
#pragma unroll
        for (int s8 = 0; s8 < 8; ++s8) kfa[s8] = *(const bf16x8*)(kr + 16 * s8);
#pragma unroll
        for (int jj = 0; jj < 16; ++jj) vqa[jj] = *(const half4*)(vr + (size_t)(16 * (jj >> 3) + 8 * ((jj >> 2) & 1) + (jj & 3)) * NIN);
        __builtin_amdgcn_sched_barrier(0);
#pragma unroll
        for (int s8 = 0; s8 < 8; ++s8) sacc = __builtin_amdgcn_mfma_f32_32x32x16_bf16(kfa[s8], qf[s8], sacc, 0, 0, 0);
        const bool diag = (st2 == tt); half8 wf[2];
#pragma unroll
        for (int i2 = 0; i2 < 16; ++i2) { const int kc = (i2 & 3) + 8 * (i2 >> 2) + 4 * hh; const bool valid = !diag || (kc <= r); wf[i2 >> 3][i2 & 7] = (h16)(valid ? sacc[i2] : 0.f); }
#pragma unroll
        for (int s2 = 0; s2 < 2; ++s2) { half8 vf[4];
#pragma unroll
            for (int jj = 0; jj < 8; ++jj) { const half4 v4 = vqa[8 * s2 + jj]; vf[0][jj] = v4[0]; vf[1][jj] = v4[1]; vf[2][jj] = v4[2]; vf[3][jj] = v4[3]; }
#pragma unroll
            for (int mt = 0; mt < 4; ++mt) oacc[mt] = __builtin_amdgcn_mfma_f32_32x32x16_f16(vf[mt], wf[s2], oacc[mt], 0, 0, 0); }
    }
    float q = 0.f;
#pragma unroll
    for (int mt = 0; mt < 4; ++mt)
#pragma unroll
        for (int i2 = 0; i2 < 16; ++i2) q += oacc[mt][i2] * oacc[mt][i2];
    q += __shfl_xor(q, 32);
    const float rr = rsqrtf_(q * (1.f / 128.f) + opq_f(RMS_EPS));
    const h16* gp = P + tq * NIN + 1536 + h * 128; h16* orow = MIX + tq * DM + h * 128;
    half4 g4a[16]; f32x4 n4a[16];
#pragma unroll
    for (int i2 = 0; i2 < 16; ++i2) { const int v0 = 4 * ((i2 & 3) + 8 * (i2 >> 2) + 4 * hh); g4a[i2] = *(const half4*)(gp + v0); n4a[i2] = *(const f32x4*)(ng + h * 128 + v0); }
#pragma unroll
    for (int i2 = 0; i2 < 16; ++i2) { const int v0 = 4 * ((i2 & 3) + 8 * (i2 >> 2) + 4 * hh);
        float o[4];
#pragma unroll
        for (int mt = 0; mt < 4; ++mt) o[mt] = oacc[mt][i2] * rr * n4a[i2][mt] * siluf_((float)g4a[i2][mt]);
        u32x2 w; w.x = pkh(o[0], o[1]); w.y = pkh(o[2], o[3]); *(u32x2*)(orow + v0) = w; }
}
DI void finalize_rows(const Frame& F, int l) { PHASE_IDS
    h16* MIX = wsp<h16>(F, WS_H16);
    const h16* RAW = wsp<h16>(F, WS_RWRAW); const unsigned char* REC = wsp<unsigned char>(F, WS_RWREC); const float* BON = wsp<float>(F, WS_RWBON); const h16* GG = wsp<h16>(F, WS_LR16);
    const int c0 = 8 * lane, hd = lane >> 3, kcol = c0 & 63;
    float gg[8], gb[8];
#pragma unroll
    for (int j = 0; j < 8; ++j) { gg[j] = inp(F, I_RWGNG)[l * DG + c0 + j]; gb[j] = inp(F, I_RWGNB)[l * DG + c0 + j]; }
    for (int row0 = gw; row0 < M; row0 += 2 * NGW) { half8 xr[2], gr[2]; u32x4 vr2[2]; float bsr[2];
#pragma unroll
        for (int u = 0; u < 2; ++u) { const int row = (row0 + u * NGW) < M ? (row0 + u * NGW) : M - 1; const int b = row >> 12, sq = row & (SEQ - 1);
            xr[u] = *(const half8*)(RAW + (size_t)row * DG + c0); gr[u] = *(const half8*)(GG + (size_t)row * 1536 + 1024 + c0);
            vr2[u] = *(const u32x4*)(REC + ((size_t)(b * 8 + hd) * 256 + (sq >> 4)) * RR_BYTES + RR_VV + ((sq & 15) * 64 + kcol) * 2); bsr[u] = BON[(size_t)row * 8 + hd]; }
#pragma unroll
        for (int u = 0; u < 2; ++u) { const int row = row0 + u * NGW; if (row < M) {
        float x[8], g[8]; h8_to_f(xr[u], x); h8_to_f(gr[u], g); const u32x4 vv = vr2[u]; const float bs = bsr[u];
        const float v[8] = {bf2f((unsigned short)(vv.x & 0xffffu)), bf2f((unsigned short)(vv.x >> 16)), bf2f((unsigned short)(vv.y & 0xffffu)), bf2f((unsigned short)(vv.y >> 16)),
                            bf2f((unsigned short)(vv.z & 0xffffu)), bf2f((unsigned short)(vv.z >> 16)), bf2f((unsigned short)(vv.w & 0xffffu)), bf2f((unsigned short)(vv.w >> 16))};
        float sx = 0.f;
#pragma unroll
        for (int j = 0; j < 8; ++j) sx += x[j];
        sx = sum8(sx); const float mean = sx * (1.f / 64.f); float qq = 0.f;
#pragma unroll
        for (int j = 0; j < 8; ++j) { x[j] -= mean; qq += x[j] * x[j]; }
        qq = sum8(qq); const float rstd = rsqrtf_(qq * (1.f / 64.f) + opq_f(GN_EPS)); float o[8];
#pragma unroll
        for (int j = 0; j < 8; ++j) o[j] = (x[j] * rstd * gg[j] + gb[j] + bs * v[j]) * g[j];
        *(half8*)(MIX + (size_t)row * DM + 1536 + c0) = f_to_h8(o); } }
    }
}

constexpr int PH_PER_LAYER = 11, N_PHASES = 2 + DEPTH * PH_PER_LAYER;
__global__ void __launch_bounds__(NWAVES * 64, 2) hse_fwd(Args args) {
    extern __shared__ __attribute__((aligned(16))) unsigned char lds_raw[];
    Frame F;
    F.lds = (LAS unsigned char*)lds_raw;
    const int G = gridDim.x, wave = __builtin_amdgcn_readfirstlane(threadIdx.x >> 6);
    F.ws = args.ws; F.out = args.out; F.wave = wave;
    volatile LAS unsigned* MISC = (volatile LAS unsigned*)(F.lds + MISC_OFF);
    if (threadIdx.x < 16) MISC[threadIdx.x] = 0u;
    __syncthreads();
#if MK_LAUNCH_MODE == 0
    XcdBarrier bar = xcd_barrier_post((unsigned*)(F.ws + WS_CTL) + CW_BAR, MISC + 8, wave);
#define GRID_BAR() xcd_barrier(bar)
#else
#define GRID_BAR() do {} while (0)
#endif
    const int lo = args.ph_lo, hi = args.ph_hi;
#define IN(k) (lo <= (k) && (k) < hi)
#define SEAM(k) do { if (IN((k) + 1)) GRID_BAR(); } while (0)
#define MOD wsp<float>(F, WS_MOD)
#define X wsp<float>(F, WS_X)
#define H16 wsp<h16>(F, WS_H16)
#define PROJ wsp<h16>(F, WS_PROJ)
    LAS unsigned char* ring = F.lds;

    if (PHE(11) && IN(0)) { p0_mod(F); s5_pow_tables(F, 0); convert_weights(F, 0, 2, wave, 8, wave * 16384); SEAM(0); }
    if (PHE(12) && IN(1)) { modulate_rows(F, inp(F, I_X), MOD, 0, H16); convert_weights(F, 0, 5, wave, 8, wave * 16384); SEAM(1); }

    for (int l = 0; l < DEPTH; ++l) {
        const int pb = 2 + l * PH_PER_LAYER;
#define modl (MOD + (size_t)l * BATCH * MODW)
        if (PHE(0) && IN(pb + 0)) { REPB(0, pg8::Gemm g{H16, wsp<h16>(F, WS_WIN), DM, DM, DM, 0, 0}; pg8::StaticOrder S; S.init(M, NIN, G, opq_bid());
            pg8::EpiProj E{PROJ, wsp<h16>(F, WS_UG)}; pg8::gemm_phase<pg8::EpiProj, pg8::StaticOrder, true>(ring, g, S, E, wave););
            SEAM(pb + 0); }
        if (PHE(1) && IN(pb + 1)) { REPB(1, { pg8::Gemm g{wsp<h16>(F, WS_UG), wsp<h16>(F, WS_S5T1), S5K3, 512, 512, (long)S5NC * S5K3, 256L * 512}; pg8::GroupOrder S; S.init(4, 1, 32, G, opq_bid());
                pg8::EpiS5h E{wsp<float>(F, WS_HLOC)}; if (PHE(15)) pg8::gemm_phase<pg8::EpiS5h, pg8::GroupOrder, true>(ring, g, S, E, wave); }
            __syncthreads();
            if (PHE(14)) { prep_rows(F, l); hgrn_prep(F, l); });
            SEAM(pb + 1); }
        if (PHE(2) && IN(pb + 2)) { REPB(2, { pg8::Gemm g{wsp<h16>(F, WS_RWA), wsp<h16>(F, WS_LRT), 256, 256, 256, 0, 0}; pg8::StaticOrder S; S.init(M, 1536, G, opq_bid());
                pg8::EpiLR E{wsp<h16>(F, WS_LR16)};
                if (PHE(17)) pg8::gemm_phase<pg8::EpiLR, pg8::StaticOrder, true>(ring, g, S, E, wave); }
            if (PHE(16)) { s5_chunk_scan(F, l); hgrn_loc_units(F); });
            SEAM(pb + 2); }
        if (PHE(3) && IN(pb + 3)) { REPB(3, { pg8::Gemm g{wsp<h16>(F, WS_UG), wsp<h16>(F, WS_S5T3), S5K3, S5K3, S5K3, (long)S5NC * S5K3, 512L * S5K3}; pg8::GroupOrder S; S.init(4, 2, 32, G, opq_bid());
                pg8::EpiS5y E{PROJ, inp(F, I_S5D) + l * DG, wsp<h16>(F, WS_Y16)}; pg8::gemm_phase<pg8::EpiS5y, pg8::GroupOrder, true>(ring, g, S, E, wave); }
            rwkv_chunk_prep(F, l); hgrn_state_scan(F); if (l + 1 < DEPTH) s5_pow_tables(F, l + 1); rwkv_sync_zero(F););
            SEAM(pb + 3); }
        if (PHE(4) && IN(pb + 4)) { REPB(4, if (wave == 0) rwkv_scan_consumer(F);
            else if (wave == 4 || wave == 5) rwkv_scan_loader(F, wave - 4);
            else { const int ws5 = wave < 4 ? wave - 1 : wave - 3; const float* ng = inp(F, I_HGNG) + l * DG;
                for (int un = opq_bid() * 5 + ws5; un < BATCH * 4 * 64 * 2; un += G * 5) hgrn_out_unit(F, un, ng);
                if (PHE(13)) attention_units(F, ws5, 5); if (l + 1 < DEPTH) convert_weights(F, l + 1, 4, ws5, 5, 0); });
            SEAM(pb + 4); }
        if (PHE(5) && IN(pb + 5)) { REPB(5, { pg8::Gemm g{wsp<h16>(F, WS_Y16), wsp<h16>(F, WS_GLU), DG, DG, DG, 0, 0}; pg8::StaticOrder S; S.init(M, DG, G, opq_bid());
                pg8::EpiGLU E{wsp<h16>(F, WS_Y16), inp(F, I_GLUB) + l * DG, H16}; pg8::gemm_phase<pg8::EpiGLU, pg8::StaticOrder, true>(ring, g, S, E, wave); }
            finalize_rows(F, l););
            SEAM(pb + 5); }
        if (PHE(6) && IN(pb + 6)) { REPB(6, pg8::Gemm g{H16, wsp<h16>(F, WS_WOUT), DM, DM, DM, 0, 0}; pg8::StaticOrder S; S.init(M, DM, G, opq_bid());
            pg8::EpiRes E{l == 0 ? inp(F, I_X) : X, X, modl + 2 * DM, l == 0 ? (const float*)nullptr : wsp<float>(F, WS_LNST), inp(F, I_LN2G) + (l > 0 ? l - 1 : 0) * DM, inp(F, I_LN2B) + (l > 0 ? l - 1 : 0) * DM};
            pg8::gemm_phase<pg8::EpiRes, pg8::StaticOrder, true>(ring, g, S, E, wave););
            SEAM(pb + 6); }
        if (PHE(7) && IN(pb + 7)) { REPB(7, ln_rows(F, X, (float*)nullptr, inp(F, I_LN1G) + l * DM, inp(F, I_LN1B) + l * DM, modl, 3, H16, wsp<float>(F, WS_LNST)););
            SEAM(pb + 7); }
        if (PHE(8) && IN(pb + 8)) { REPB(8, pg8::Gemm g{H16, wsp<h16>(F, WS_W13), DM, DM, DM, 0, 0}; pg8::StaticOrder S; S.init(M, 2 * DFF, G, opq_bid());
            pg8::EpiSwiGLU E{PROJ}; pg8::gemm_phase<pg8::EpiSwiGLU, pg8::StaticOrder, true>(ring, g, S, E, wave););
            SEAM(pb + 8); }
        if (PHE(9) && IN(pb + 9)) { REPB(9, pg8::Gemm g{PROJ, wsp<h16>(F, WS_W2), DFF, DFF, DFF, 0, 0}; pg8::StaticOrder S; S.init(M, DM, G, opq_bid());
            pg8::EpiRes E{X, X, modl + 5 * DM, wsp<float>(F, WS_LNST), inp(F, I_LN1G) + l * DM, inp(F, I_LN1B) + l * DM}; pg8::gemm_phase<pg8::EpiRes, pg8::StaticOrder, true>(ring, g, S, E, wave););
            SEAM(pb + 9); }
        if (PHE(10) && IN(pb + 10)) { REPB(10, const bool lastl = (l == DEPTH - 1);
            ln_rows(F, X, lastl ? F.out : (float*)nullptr, inp(F, I_LN2G) + l * DM, inp(F, I_LN2B) + l * DM, modl + (size_t)BATCH * MODW, 0, lastl ? (h16*)nullptr : H16, lastl ? (float*)nullptr : wsp<float>(F, WS_LNST));
            if (!lastl) { __syncthreads(); convert_weights(F, l + 1, 3, wave, 8, wave * 16384); });
            SEAM(pb + 10); }
    }
#undef IN
#undef SEAM
#undef MOD
#undef X
#undef H16
#undef PROJ
#undef modl
}

extern "C" void kernel_launch(void* const* d_in, const int* in_sizes, int n_in, void* d_out, int out_size, void* d_ws, size_t ws_size, hipStream_t stream) {
    static int grid = 0;
    if (grid == 0) {
        if (n_in != 36 || in_sizes[0] != M * DM || out_size != M * DM || ws_size < WS_END) { fprintf(stderr, "kernel_launch: unexpected shapes (n_in %d, in0 %d, out %d, ws %zu)\n", n_in, n_in > 0 ? in_sizes[0] : -1, out_size, ws_size); grid = -1; return; }
        int dev = 0, cus = 0, per_cu = 0;
        if (hipGetDevice(&dev) != hipSuccess || hipDeviceGetAttribute(&cus, hipDeviceAttributeMultiprocessorCount, dev) != hipSuccess) { grid = -1; return; }
        if (hipFuncSetAttribute((const void*)hse_fwd, hipFuncAttributeMaxDynamicSharedMemorySize, LDS_BYTES) != hipSuccess) { fprintf(stderr, "kernel_launch: hipFuncSetAttribute failed\n"); grid = -1; return; }
        if (hipOccupancyMaxActiveBlocksPerMultiprocessor(&per_cu, (const void*)hse_fwd, NWAVES * 64, LDS_BYTES) != hipSuccess || per_cu < 1) { fprintf(stderr, "kernel_launch: occupancy query reports %d\n", per_cu); }
        (void)hipGetLastError();
        grid = cus;
    }
    if (grid < 0) return;
    if (hipMemsetAsync((char*)d_ws + WS_CTL, 0, CTL_ZERO_BYTES, stream) != hipSuccess) return;
    Args a{};
    for (int i = 0; i < 36; ++i) a.in[i] = (const float*)d_in[i];
    a.out = (float*)d_out; a.ws = (unsigned char*)d_ws;
#if MK_LAUNCH_MODE == 0
    a.ph_lo = 0; a.ph_hi = N_PHASES;
    hipLaunchKernelGGL(hse_fwd, dim3(grid), dim3(NWAVES * 64), LDS_BYTES, stream, a);
#else
    for (int p = 0; p < N_PHASES; ++p) { a.ph_lo = p; a.ph_hi = p + 1; hipLaunchKernelGGL(hse_fwd, dim3(grid), dim3(NWAVES * 64), LDS_BYTES, stream, a); }
#endif
}
```

```cpp
#include <hip/hip_runtime.h>
#include <cstdio>
#include <cstdint>

#ifndef MK_LAUNCH_MODE
#define MK_LAUNCH_MODE 0
#endif

#ifndef PH_ENABLE
#define PH_ENABLE 0xFFFFF
#endif
#define PHE(k) (((PH_ENABLE) >> (k)) & 1)
#ifndef REPEAT_MASK
#define REPEAT_MASK 0
#endif
#define REPB(k, ...) do { __VA_ARGS__ if ((REPEAT_MASK >> (k)) & 1) { __syncthreads(); __VA_ARGS__ } } while (0)
#define LAS __attribute__((address_space(3)))
typedef _Float16 h16;
typedef _Float16 half8 __attribute__((ext_vector_type(8)));
typedef _Float16 half4 __attribute__((ext_vector_type(4)));
typedef _Float16 half2v __attribute__((ext_vector_type(2)));
typedef float f32x4 __attribute__((ext_vector_type(4)));
typedef float f32x2 __attribute__((ext_vector_type(2)));
typedef unsigned u32x4 __attribute__((ext_vector_type(4)));
typedef unsigned u32x2 __attribute__((ext_vector_type(2)));

constexpr int BATCH = 8, SEQ = 4096, DM = 2048, DEPTH = 4, M = BATCH * SEQ;
constexpr int DG = 512, NIN = 5888, RWOFF = 4096, DFF = 5632;
constexpr int MODW = 6 * DM;
constexpr float DN_ALPHA = 1.681792830507429f;
constexpr float LN_EPS = 1e-5f, RMS_EPS = 1e-6f, GN_EPS = 64e-5f;
constexpr int S5L = 32, S5NC = M / S5L;
constexpr int S5K3 = 640;

constexpr size_t MiB = 1u << 20;
constexpr size_t WS_CTL = 0, CTL_ZERO_BYTES = 64 * 1024;
constexpr size_t WS_MOD = 1 * MiB;
constexpr size_t WS_LB = 3 * MiB;
constexpr size_t WS_W16 = 16 * MiB;
constexpr size_t WS_WIN = WS_W16;
constexpr size_t WS_WOUT = WS_WIN + 23 * MiB;
constexpr size_t WS_W13 = WS_WOUT + 8 * MiB;
constexpr size_t WS_W2 = WS_W13 + 44 * MiB;
constexpr size_t WS_GLU = WS_W2 + 22 * MiB;
constexpr size_t WS_LRT = WS_GLU + 1 * MiB;
constexpr size_t WS_S5T3 = WS_LRT + 1 * MiB;
constexpr size_t WS_S5T1 = WS_S5T3 + 20 * MiB;
constexpr size_t WS_X = 152 * MiB;
constexpr size_t WS_H16 = 408 * MiB;
constexpr size_t WS_PROJ = 536 * MiB;
constexpr size_t WS_RWA = 904 * MiB;
constexpr size_t WS_HLOC = 920 * MiB;
constexpr size_t WS_Y16 = 904 * MiB;
constexpr size_t WS_LR16 = 936 * MiB;
constexpr size_t WS_RWREC = 1032 * MiB;
constexpr size_t WS_RWBON = 1240 * MiB;
constexpr size_t WS_HGK = 1256 * MiB;
constexpr size_t WS_HGQ = 1288 * MiB;
constexpr size_t WS_HGST = 1320 * MiB;
constexpr size_t WS_UG = 1384 * MiB;
constexpr size_t WS_RWRAW = 1384 * MiB;
constexpr size_t WS_LNST = 8 * MiB;
constexpr size_t WS_LPW = 6 * MiB;
constexpr size_t WS_BBR = 7 * MiB;
constexpr size_t WS_HGB = 4 * MiB;
constexpr size_t WS_END = 1424 * MiB;
static_assert(WS_S5T1 + 8 * MiB <= WS_X, "W16 map");
constexpr int CW_BAR = 1024;

constexpr int RING_BYTES = 131072, MISC_OFF = RING_BYTES + 64, LDS_BYTES = 147456;
constexpr int NWAVES = 8;

#define DI __device__ __forceinline__
DI int opq_lane() { int l; asm volatile("v_mbcnt_lo_u32_b32 %0, -1, 0\n\tv_mbcnt_hi_u32_b32 %0, -1, %0" : "=v"(l)); return l; }
DI unsigned pkh(float a, float b) { half2v h; h.x = (h16)a; h.y = (h16)b; return __builtin_bit_cast(unsigned, h); }
DI float sigmoidf_(float x) { return __builtin_amdgcn_rcpf(1.f + __expf(-x)); }
DI float siluf_(float x) { return x * sigmoidf_(x); }
DI float tanhf_(float x) { const float t = __expf(-2.f * fabsf(x)); const float r = (1.f - t) * __builtin_amdgcn_rcpf(1.f + t); return x < 0.f ? -r : r; }
DI float softplusf_(float x) { return fmaxf(x, 0.f) + 0.6931471805599453f * __builtin_amdgcn_logf(1.f + __expf(-fabsf(x))); }
DI float rsqrtf_(float x) { return __builtin_amdgcn_rsqf(x); }
DI float gelu_tanhf_(float y) { const float u = 1.5957691216057308f * (y + 0.044715f * y * y * y); return y * sigmoidf_(u); }
template <int CTRL> DI float dppf(float v) { return __builtin_bit_cast(float, __builtin_amdgcn_update_dpp(0, __builtin_bit_cast(int, v), CTRL, 0xf, 0xf, false)); }
DI float sum4(float v) { v += dppf<0xB1>(v); v += dppf<0x4E>(v); return v; }
DI float sum8(float v) { v = sum4(v); v += dppf<0x141>(v); return v; }
DI float sum16(float v) { v = sum8(v); v += dppf<0x140>(v); return v; }
DI float wave_sum(float v) {
#pragma unroll
    for (int o = 1; o < 64; o <<= 1) v += __shfl_xor(v, o);
    return v;
}
typedef short bf16x8 __attribute__((ext_vector_type(8)));
typedef short bf16x4 __attribute__((ext_vector_type(4)));
DI unsigned short f2bf(float f) { unsigned u = __builtin_bit_cast(unsigned, f); return (unsigned short)((u + 0x7fffu + ((u >> 16) & 1u)) >> 16); }
DI float bf2f(unsigned short b) { return __builtin_bit_cast(float, (unsigned)b << 16); }
DI void h8_to_f(const half8 h, float (&f)[8]) {
#pragma unroll
    for (int i = 0; i < 8; ++i) f[i] = (float)h[i];
}
DI half8 f_to_h8(const float (&f)[8]) { half8 h;
#pragma unroll
    for (int i = 0; i < 8; ++i) h[i] = (h16)f[i];
    return h; }

#define XB_TMO      128
#define XB_XCNT(j)  (256  + 64 * (j))
#define XB_XSUB(j)  (1280 + 64 * (j))
#define XB_XGEN(j)  (2304 + 64 * (j))
#define XB_TOP      3328
#define XB_TOPGEN   3392
#define XCD_BAR_WORDS 3456
#define XB_SPIN_CAP (1u << 20)
__device__ __forceinline__ unsigned xb_ld(unsigned* p)              { return __hip_atomic_load(p, __ATOMIC_RELAXED, __HIP_MEMORY_SCOPE_AGENT); }
__device__ __forceinline__ unsigned xb_add(unsigned* p, unsigned v) { return __hip_atomic_fetch_add(p, v, __ATOMIC_RELAXED, __HIP_MEMORY_SCOPE_AGENT); }
__device__ __forceinline__ unsigned xb_xcc_id() { return (unsigned)__builtin_amdgcn_s_getreg((3 << 11) | 20) & 0xFu; }
#define XB_SPIN(cond, bar) do { unsigned _sp = 0; while (cond) { __builtin_amdgcn_s_sleep(1); \
    if ((++_sp & 255u) == 0u) { if (xb_ld(&(bar)[XB_TMO])) break; if (_sp > XB_SPIN_CAP) { atomicAdd(&(bar)[XB_TMO], 1u); break; } } } } while (0)
struct XcdBarrier { unsigned* bar; unsigned x; volatile LAS unsigned* st; int wave; };
__device__ __forceinline__ XcdBarrier xcd_barrier_post(unsigned* bar, volatile LAS unsigned* st, int wave) {
    XcdBarrier b; b.bar = bar; b.x = xb_xcc_id(); b.st = st; b.wave = wave;
    if (wave == 0 && opq_lane() == 0) (void)xb_add(&bar[XB_XCNT(b.x)], 1u);
    return b;
}
__device__ __forceinline__ void xcd_barrier_complete(unsigned* bar, unsigned x, unsigned& nloc, unsigned& nx) {
    const unsigned G = gridDim.x * gridDim.y * gridDim.z;
    asm volatile("" : "+s"(x));
    unsigned sum, cnt, mine, sp = 0u;
    for (;;) {
        sum = 0u; cnt = 0u; mine = 0u;
#pragma unroll
        for (unsigned j = 0; j < 16; ++j) { const unsigned c = xb_ld(&bar[XB_XCNT(j)]); sum += c; cnt += (c > 0u) ? 1u : 0u; mine = (j == x) ? c : mine; }
        if (sum == G) break;
        __builtin_amdgcn_s_sleep(1);
        if ((++sp & 255u) == 0u) { if (xb_ld(&bar[XB_TMO])) break; if (sp > XB_SPIN_CAP) { atomicAdd(&bar[XB_TMO], 1u); break; } }
    }
    nloc = mine > 0u ? mine : 1u; nx = cnt > 0u ? cnt : 1u;
}
__device__ __forceinline__ void xcd_barrier(const XcdBarrier& b) {
    asm volatile("s_waitcnt vmcnt(0)" ::: "memory");
    __syncthreads();
    if (b.wave == 0 && opq_lane() == 0) {
        unsigned* bar = b.bar; asm volatile("" : "+s"(bar));
        __builtin_amdgcn_s_waitcnt(0);
        unsigned nloc = b.st[0], nx = b.st[1];
        if (nloc == 0u) { xcd_barrier_complete(bar, b.x, nloc, nx); b.st[0] = nloc; b.st[1] = nx; }
        const unsigned old = xb_add(&bar[XB_XSUB(b.x)], 1u);
        const unsigned gen = old / nloc;
        if (old + 1u == (gen + 1u) * nloc) {
            __builtin_amdgcn_fence(__ATOMIC_RELEASE, "agent");
            asm volatile("s_waitcnt vmcnt(0)" ::: "memory");
            const unsigned og = xb_add(&bar[XB_TOP], 1u);
            const unsigned tg = og / nx;
            if (og + 1u == (tg + 1u) * nx) xb_add(&bar[XB_TOPGEN], 1u);
            else XB_SPIN(xb_ld(&bar[XB_TOPGEN]) == tg, bar);
            __builtin_amdgcn_fence(__ATOMIC_ACQUIRE, "agent");
            xb_add(&bar[XB_XGEN(b.x)], 1u);
            asm volatile("s_waitcnt vmcnt(0)" ::: "memory");
        } else {
            XB_SPIN(xb_ld(&bar[XB_XGEN(b.x)]) == gen, bar);
            __builtin_amdgcn_fence(__ATOMIC_ACQUIRE, "agent");
            asm volatile("s_waitcnt vmcnt(0)" ::: "memory");
        }
    }
    __syncthreads();
}

namespace pg8 {
constexpr int BM = 256, BK = 64, HALF = 128, HTB = HALF * BK * 2, STAGE_BYTES = 8 * HTB, NXCD = 8, WGM = 8;
__host__ __device__ __forceinline__ int lds_byte(int r, int c) { const int st = (r >> 4) * 2 + (c >> 5), rr = r & 15, cc = c & 31, ob = rr * 64 + cc * 2; return st * 1024 + (ob ^ (((ob >> 9) & 1) << 5)); }
__host__ __device__ __forceinline__ void stage_rc(int b, int& R, int& C) { const int st = b / 1024, sb = b % 1024, swz = sb ^ (((sb >> 9) & 1) << 5); R = (st >> 1) * 16 + swz / 64; C = (st & 1) * 32 + (swz % 64) / 2; }
__host__ __device__ __forceinline__ int perm32(int rho) { const int n = rho >> 4, i = rho & 15; return 8 * (i >> 2) + 4 * n + (i & 3); }

struct Unit { int pm, pn, g; };
struct Gemm { const h16* A; const h16* Bt; int lda, ldb, K; long gsA, gsB; };

struct StaticOrder {
    int nM, nN, nwg, G, c;
    __device__ void init(int M_, int N_, int G_, int c_) { nM = M_ / BM; nN = N_ / BM; nwg = nM * nN; G = G_; c = c_; }
    __device__ bool next(int i, Unit& u) const {
        const long L = (long)i * G + c; if (L >= nwg) return false;
        int wgid = (int)L; { const int q = nwg / NXCD, r = nwg % NXCD, xcd = wgid % NXCD, off = wgid / NXCD; wgid = (xcd < r ? xcd * (q + 1) : r * (q + 1) + (xcd - r) * q) + off; }
        const int nig = WGM * nN, gid = wgid / nig, fm = gid * WGM, gsz = (nM - fm) < WGM ? (nM - fm) : WGM;
        u.pm = fm + ((wgid % nig) % gsz); u.pn = (wgid % nig) / gsz; u.g = 0; return true;
    }
};
struct GroupOrder {
    int nM, nN, per, total, G, c;
    __device__ void init(int nM_, int nN_, int ng, int G_, int c_) { nM = nM_; nN = nN_; per = nM_ * nN_; total = per * ng; G = G_; c = c_; }
    __device__ bool next(int i, Unit& u) const {
        const long L = (long)i * G + c; if (L >= total) return false;
        const int l = (int)L; u.g = l / per; const int r = l % per; u.pm = r % nM; u.pn = r / nM; return true;
    }
};

__device__ __forceinline__ void glds16_s(const char* gbase, unsigned voff, unsigned lds_dst) {
    unsigned keep;
    asm volatile("s_mov_b32 %0, m0\n\ts_mov_b32 m0, %2\n\ts_nop 0\n\tglobal_load_lds_dwordx4 %1, %3\n\ts_mov_b32 m0, %0" : "=&s"(keep) : "v"(voff), "s"(lds_dst), "s"(gbase) : "memory");
}
template <class Epi, class Sched, bool ALIGN_EPI>
__device__ __forceinline__ void gemm_phase(LAS unsigned char* lds, const Gemm g, const Sched& S, const Epi& E, const int wid_in) {
    int lane; asm volatile("v_mbcnt_lo_u32_b32 %0, -1, 0\n\tv_mbcnt_hi_u32_b32 %0, -1, %0" : "=v"(lane));
    int wid = wid_in; asm volatile("" : "+s"(wid));
    const int tid = wid * 64 + lane, wr = wid >> 2, wc = wid & 3, fr = lane & 15, fq = lane >> 4;
    const int K = g.K, nt = K / BK;
    unsigned voffA[2], voffB[2];
#pragma unroll
    for (int i = 0; i < 2; ++i) { int R, C; stage_rc(tid * 16 + i * 8192, R, C); const int Rb = Epi::PERM ? ((R & ~31) + perm32(R & 31)) : R;
        voffA[i] = (unsigned)(R * g.lda + C) * 2u; voffB[i] = (unsigned)(Rb * g.ldb + C) * 2u; }
    const size_t kstep = (size_t)(BK * 2);
    const size_t hstepA = (size_t)HALF * g.lda * 2, hstepB = (size_t)HALF * g.ldb * 2;
    const size_t tstepA = 2 * hstepA, tstepB = 2 * hstepB;
    const unsigned ldsw = (unsigned)wid * 1024u, lds_u = (unsigned)(size_t)lds;
    const int aoff = lds_byte(wr * 64 + fr, fq * 8), boff = lds_byte(wc * 32 + fr, fq * 8);
#define PG8_SA(b, h) (((b) * 2 + (h)) * HTB)
#define PG8_SB(b, h) ((4 + (b) * 2 + (h)) * HTB)
#define PG8_STAGE(bufoff, gbase, voff) do { _Pragma("unroll") for (int _i = 0; _i < 2; ++_i) glds16_s((const char*)(gbase), (voff)[_i], lds_u + (unsigned)((bufoff) + _i * 8192) + ldsw); } while (0)
#define PG8_LDA(dst, b, h) do { _Pragma("unroll") for (int m = 0; m < 4; ++m) _Pragma("unroll") for (int k = 0; k < 2; ++k) dst[m][k] = *(const LAS half8*)(lds + PG8_SA(b, h) + aoff + m * 2048 + k * 1024); } while (0)
#define PG8_LDB(dst, b, h) do { _Pragma("unroll") for (int n = 0; n < 2; ++n) _Pragma("unroll") for (int k = 0; k < 2; ++k) dst[n][k] = *(const LAS half8*)(lds + PG8_SB(b, h) + boff + n * 2048 + k * 1024); } while (0)
#define PG8_MMA(ai, bj, At, Bt) do { __builtin_amdgcn_s_setprio(1); _Pragma("unroll") for (int m = 0; m < 4; ++m) _Pragma("unroll") for (int n = 0; n < 2; ++n) _Pragma("unroll") for (int k = 0; k < 2; ++k) \
        acc[ai][bj][m][n] = __builtin_amdgcn_mfma_f32_16x16x32_f16(Bt[n][k], At[m][k], acc[ai][bj][m][n], 0, 0, 0); __builtin_amdgcn_s_setprio(0); } while (0)
#define PG8_WAIT_V(n) asm volatile("s_waitcnt vmcnt(" #n ")" ::: "memory")
#define PG8_WAIT_L(n) asm volatile("s_waitcnt lgkmcnt(" #n ")" ::: "memory")
#define PG8_BAR __builtin_amdgcn_s_barrier()
#define PG8_SCHED __builtin_amdgcn_sched_barrier(0)
    Unit cur, nxt; int ui = 0;
    if (!S.next(0, cur)) return;
    f32x4 acc[2][2][4][2];
#pragma unroll
    for (int a = 0; a < 2; ++a)
#pragma unroll
        for (int b = 0; b < 2; ++b)
#pragma unroll
            for (int m = 0; m < 4; ++m)
#pragma unroll
                for (int n = 0; n < 2; ++n) acc[a][b][m][n] = (f32x4){0.f, 0.f, 0.f, 0.f};
    half8 At[4][2], B0[2][2], B1[2][2];
    const char* cA = (const char*)g.A + (size_t)cur.g * g.gsA * 2 + (size_t)cur.pm * tstepA;
    const char* cB = (const char*)g.Bt + (size_t)cur.g * g.gsB * 2 + (size_t)cur.pn * tstepB;
    PG8_STAGE(PG8_SB(0, 0), cB, voffB); PG8_STAGE(PG8_SB(0, 1), cB + hstepB, voffB); PG8_STAGE(PG8_SA(0, 0), cA, voffA); PG8_STAGE(PG8_SA(0, 1), cA + hstepA, voffA);
    if (wr == 1) PG8_BAR;
    PG8_WAIT_V(2); PG8_BAR;
    PG8_STAGE(PG8_SB(1, 0), cB + kstep, voffB); PG8_STAGE(PG8_SA(1, 0), cA + kstep, voffA); PG8_STAGE(PG8_SB(1, 1), cB + hstepB + kstep, voffB);
    PG8_WAIT_V(6); PG8_BAR;
    for (;;) {
        const bool has_next = S.next(ui + 1, nxt);
        const char* nA = has_next ? (const char*)g.A + (size_t)nxt.g * g.gsA * 2 + (size_t)nxt.pm * tstepA : cA;
        const char* nB = has_next ? (const char*)g.Bt + (size_t)nxt.g * g.gsB * 2 + (size_t)nxt.pn * tstepB : cB;
        for (int t = 0; t < nt; t += 2) {
            const bool last = (t == nt - 2);
            const char* a1 = cA + (size_t)(t + 1) * kstep;
            const char* a2 = last ? nA : cA + (size_t)(t + 2) * kstep; const char* b2 = last ? nB : cB + (size_t)(t + 2) * kstep;
            const char* a3 = a2 + kstep; const char* b3 = b2 + kstep;
            PG8_LDB(B0, 0, 0); PG8_LDB(B1, 0, 1); PG8_SCHED; PG8_LDA(At, 0, 0); PG8_STAGE(PG8_SA(1, 1), a1 + hstepA, voffA);
            PG8_WAIT_V(8); PG8_WAIT_L(0); PG8_BAR; PG8_MMA(0, 0, At, B0); PG8_MMA(0, 1, At, B1); PG8_BAR; PG8_SCHED;
            PG8_LDA(At, 0, 1); PG8_STAGE(PG8_SB(0, 0), b2, voffB); PG8_STAGE(PG8_SB(0, 1), b2 + hstepB, voffB); PG8_STAGE(PG8_SA(0, 0), a2, voffA);
            PG8_WAIT_V(8); PG8_WAIT_L(0); PG8_BAR; PG8_MMA(1, 0, At, B0); PG8_MMA(1, 1, At, B1); PG8_BAR; PG8_SCHED;
            PG8_LDB(B0, 1, 0); PG8_LDB(B1, 1, 1); PG8_SCHED; PG8_LDA(At, 1, 0); PG8_STAGE(PG8_SA(0, 1), a2 + hstepA, voffA);
            PG8_WAIT_V(8); PG8_WAIT_L(0); PG8_BAR; PG8_MMA(0, 0, At, B0); PG8_MMA(0, 1, At, B1); PG8_BAR; PG8_SCHED;
            PG8_LDA(At, 1, 1); PG8_STAGE(PG8_SB(1, 0), b3, voffB); PG8_STAGE(PG8_SB(1, 1), b3 + hstepB, voffB); PG8_STAGE(PG8_SA(1, 0), a3, voffA);
            PG8_WAIT_V(8); PG8_WAIT_L(0); PG8_BAR; PG8_MMA(1, 0, At, B0); PG8_MMA(1, 1, At, B1); PG8_BAR; PG8_SCHED;
        }
        if constexpr (ALIGN_EPI) { if (wr == 0) PG8_BAR; }
        { int ln2; asm volatile("v_mbcnt_lo_u32_b32 %0, -1, 0\n\tv_mbcnt_hi_u32_b32 %0, -1, %0" : "=v"(ln2)); E(acc, cur, wr, wc, ln2 & 15, ln2 >> 4); }
        if (!has_next) break;
#pragma unroll
        for (int a = 0; a < 2; ++a)
#pragma unroll
            for (int b = 0; b < 2; ++b)
#pragma unroll
                for (int m = 0; m < 4; ++m)
#pragma unroll
                    for (int n = 0; n < 2; ++n) acc[a][b][m][n] = (f32x4){0.f, 0.f, 0.f, 0.f};
        cur = nxt; cA = nA; cB = nB; ++ui;
        if constexpr (ALIGN_EPI) { if (wr == 1) PG8_BAR; }
    }
    PG8_WAIT_V(0);
    if constexpr (!ALIGN_EPI) { if (wr == 0) PG8_BAR; }
    PG8_BAR;
#undef PG8_SA
#undef PG8_SB
#undef PG8_STAGE
#undef PG8_LDA
#undef PG8_LDB
#undef PG8_MMA
#undef PG8_WAIT_V
#undef PG8_WAIT_L
#undef PG8_BAR
#undef PG8_SCHED
}

typedef f32x4 Acc[2][2][4][2];

struct EpiProj {
    static constexpr bool PERM = true;
    h16* P; h16* UG;
    DI void operator()(const Acc& acc, const Unit& u, int wr, int wc, int fr, int fq) const {
        const int row0 = u.pm * BM + wr * 64 + fr, col0 = u.pn * BM + wc * 32 + 8 * fq;
        const bool s5 = (u.pn == 8 || u.pn == 9);
#pragma unroll
        for (int ai = 0; ai < 2; ++ai)
#pragma unroll
            for (int m = 0; m < 4; ++m) { const int row = row0 + ai * HALF + m * 16;
#pragma unroll
                for (int bj = 0; bj < 2; ++bj) { const f32x4 v0 = acc[ai][bj][m][0], v1 = acc[ai][bj][m][1]; const int c = col0 + bj * HALF;
                    u32x4 w; w.x = pkh(v0[0], v0[1]); w.y = pkh(v0[2], v0[3]); w.z = pkh(v1[0], v1[1]); w.w = pkh(v1[2], v1[3]);
                    *(u32x4*)(P + (size_t)row * NIN + c) = w;
                    if (s5) { const int cc = c - 2048, gg = cc >> 4, ch = cc & 15, bc = row >> 5, t = row & 31;
                        *(u32x4*)(UG + ((size_t)gg * S5NC + bc) * S5K3 + t * 16 + ch) = w; } }
                asm volatile("" ::: "memory"); }
    }
};
struct EpiRes {
    static constexpr bool PERM = false;
    const float* xin; float* xout; const float* gate;
    const float* lnst; const float* lng; const float* lnb;
    DI void operator()(const Acc& acc, const Unit& u, int wr, int wc, int fr, int fq) const {
        const int row0 = u.pm * BM + wr * 64 + fr, col0 = u.pn * BM + wc * 32 + 4 * fq, b = u.pm >> 4;
        f32x4 gv[2][2], lg[2][2], lb[2][2];
#pragma unroll
        for (int bj = 0; bj < 2; ++bj)
#pragma unroll
            for (int n = 0; n < 2; ++n) { gv[bj][n] = *(const f32x4*)(gate + (size_t)b * MODW + col0 + bj * HALF + n * 16);
                if (lnst) { lg[bj][n] = *(const f32x4*)(lng + col0 + bj * HALF + n * 16) * DN_ALPHA; lb[bj][n] = *(const f32x4*)(lnb + col0 + bj * HALF + n * 16) * DN_ALPHA; }
                else { lg[bj][n] = (f32x4){DN_ALPHA, DN_ALPHA, DN_ALPHA, DN_ALPHA}; lb[bj][n] = (f32x4){0.f, 0.f, 0.f, 0.f}; } }
#pragma unroll
        for (int ai = 0; ai < 2; ++ai)
#pragma unroll
            for (int m = 0; m < 4; ++m) { const size_t row = (size_t)(row0 + ai * HALF + m * 16); const size_t off = row * DM + col0; f32x4 xv[2][2];
                const f32x2 st = lnst ? *(const f32x2*)(lnst + 2 * row) : (f32x2){0.f, 1.f};
#pragma unroll
                for (int bj = 0; bj < 2; ++bj)
#pragma unroll
                    for (int n = 0; n < 2; ++n) xv[bj][n] = *(const f32x4*)(xin + off + bj * HALF + n * 16);
#pragma unroll
                for (int bj = 0; bj < 2; ++bj)
#pragma unroll
                    for (int n = 0; n < 2; ++n) *(f32x4*)(xout + off + bj * HALF + n * 16) = ((xv[bj][n] - st.x) * st.y) * lg[bj][n] + lb[bj][n] + gv[bj][n] * acc[ai][bj][m][n];
                asm volatile("" ::: "memory"); }
    }
};
struct EpiSwiGLU {
    static constexpr bool PERM = true;
    h16* O;
    DI void operator()(const Acc& acc, const Unit& u, int wr, int wc, int fr, int fq) const {
        const int row0 = u.pm * BM + wr * 64 + fr, col0 = u.pn * HALF + wc * 32 + 8 * fq;
#pragma unroll
        for (int ai = 0; ai < 2; ++ai)
#pragma unroll
            for (int m = 0; m < 4; ++m) { float o[8];
#pragma unroll
                for (int n = 0; n < 2; ++n)
#pragma unroll
                    for (int j = 0; j < 4; ++j) o[4 * n + j] = siluf_(acc[ai][0][m][n][j]) * acc[ai][1][m][n][j];
                u32x4 w; w.x = pkh(o[0], o[1]); w.y = pkh(o[2], o[3]); w.z = pkh(o[4], o[5]); w.w = pkh(o[6], o[7]);
                *(u32x4*)(O + (size_t)(row0 + ai * HALF + m * 16) * DFF + col0) = w; asm volatile("" ::: "memory"); }
    }
};
struct EpiLR {
    static constexpr bool PERM = true;
    h16* O;
    DI void operator()(const Acc& acc, const Unit& u, int wr, int wc, int fr, int fq) const {
        const int row0 = u.pm * BM + wr * 64 + fr, col0 = u.pn * BM + wc * 32 + 8 * fq;
#pragma unroll
        for (int ai = 0; ai < 2; ++ai)
#pragma unroll
            for (int m = 0; m < 4; ++m) { const int row = row0 + ai * HALF + m * 16;
#pragma unroll
                for (int bj = 0; bj < 2; ++bj) { const f32x4 v0 = acc[ai][bj][m][0], v1 = acc[ai][bj][m][1];
                    u32x4 w; w.x = pkh(v0[0], v0[1]); w.y = pkh(v0[2], v0[3]); w.z = pkh(v1[0], v1[1]); w.w = pkh(v1[2], v1[3]);
                    *(u32x4*)(O + (size_t)row * 1536 + col0 + bj * HALF) = w; }
                asm volatile("" ::: "memory"); }
    }
};
struct EpiS5h {
    static constexpr bool PERM = false;
    float* H;
    DI void operator()(const Acc& acc, const Unit& u, int wr, int wc, int fr, int fq) const {
        const int row0 = u.pm * BM + wr * 64 + fr, col0 = wc * 32 + 4 * fq;
#pragma unroll
        for (int ai = 0; ai < 2; ++ai)
#pragma unroll
            for (int m = 0; m < 4; ++m)
#pragma unroll
                for (int n = 0; n < 2; ++n) *(f32x4*)(H + ((size_t)u.g * S5NC + row0 + ai * HALF + m * 16) * 128 + col0 + n * 16) = acc[ai][0][m][n];
    }
};
struct EpiS5y {
    static constexpr bool PERM = true;
    const h16* P; const float* dskip; h16* Y;
    DI void operator()(const Acc& acc, const Unit& u, int wr, int wc, int fr, int fq) const {
        const int row0 = u.pm * BM + wr * 64 + fr, col0 = u.pn * BM + wc * 32 + 8 * fq;
#pragma unroll
        for (int bj = 0; bj < 2; ++bj) { const int c = col0 + bj * HALF, t = c >> 4, ch = c & 15, chan = u.g * 16 + ch;
            const f32x4 d0 = *(const f32x4*)(dskip + chan), d1 = *(const f32x4*)(dskip + chan + 4);
#pragma unroll
            for (int ai = 0; ai < 2; ++ai) { half8 uv[4];
#pragma unroll
                for (int m = 0; m < 4; ++m) { const size_t tok = (size_t)(row0 + ai * HALF + m * 16) * S5L + t; uv[m] = *(const half8*)(P + tok * NIN + 2048 + chan); }
#pragma unroll
                for (int m = 0; m < 4; ++m) { const size_t tok = (size_t)(row0 + ai * HALF + m * 16) * S5L + t; float o[8];
#pragma unroll
                    for (int j2 = 0; j2 < 4; ++j2) { o[j2] = gelu_tanhf_(acc[ai][bj][m][0][j2] + d0[j2] * (float)uv[m][j2]); o[4 + j2] = gelu_tanhf_(acc[ai][bj][m][1][j2] + d1[j2] * (float)uv[m][4 + j2]); }
                    u32x4 w; w.x = pkh(o[0], o[1]); w.y = pkh(o[2], o[3]); w.z = pkh(o[4], o[5]); w.w = pkh(o[6], o[7]);
                    *(u32x4*)(Y + tok * DG + chan) = w; }
                asm volatile("" ::: "memory"); } }
    }
};
struct EpiGLU {
    static constexpr bool PERM = true;
    const h16* Y; const float* gb; h16* MIX;
    DI void operator()(const Acc& acc, const Unit& u, int wr, int wc, int fr, int fq) const {
        const int row0 = u.pm * BM + wr * 64 + fr, col0 = u.pn * BM + wc * 32 + 8 * fq;
#pragma unroll
        for (int bj = 0; bj < 2; ++bj) { const int c = col0 + bj * HALF; const f32x4 b0 = *(const f32x4*)(gb + c), b1 = *(const f32x4*)(gb + c + 4);
#pragma unroll
            for (int ai = 0; ai < 2; ++ai) { half8 yv[4];
#pragma unroll
                for (int m = 0; m < 4; ++m) yv[m] = *(const half8*)(Y + (size_t)(row0 + ai * HALF + m * 16) * DG + c);
#pragma unroll
                for (int m = 0; m < 4; ++m) { const size_t row = (size_t)(row0 + ai * HALF + m * 16); float o[8];
#pragma unroll
                    for (int j2 = 0; j2 < 4; ++j2) { o[j2] = (float)yv[m][j2] * sigmoidf_(acc[ai][bj][m][0][j2] + b0[j2]); o[4 + j2] = (float)yv[m][4 + j2] * sigmoidf_(acc[ai][bj][m][1][j2] + b1[j2]); }
                    u32x4 w; w.x = pkh(o[0], o[1]); w.y = pkh(o[2], o[3]); w.z = pkh(o[4], o[5]); w.w = pkh(o[6], o[7]);
                    *(u32x4*)(MIX + row * DM + 512 + c) = w; }
                asm volatile("" ::: "memory"); } }
    }
};
}

struct Args { const float* in[36]; float* out; unsigned char* ws; int ph_lo, ph_hi; };
enum { I_X = 0, I_C, I_ADAW, I_ADAB, I_WIN, I_WOUT, I_HGLB, I_HGNG, I_S5ARE, I_S5AIM, I_S5LDT, I_S5BRE, I_S5BIM, I_S5CRE, I_S5CIM, I_S5D, I_GLUW, I_GLUB,
       I_RWMU, I_RWW0, I_RWW2, I_RWA0, I_RWA2, I_RWG2, I_RWKK, I_RWKA, I_RWRK, I_RWGNG, I_RWGNB, I_LN1G, I_LN1B, I_FW1, I_FW3, I_FW2, I_LN2G, I_LN2B };

struct Frame {
    LAS unsigned char* lds;
    unsigned char* ws; float* out; int wave;
};
DI int opq_bid() { int b = blockIdx.x; asm volatile("" : "+s"(b)); return b; }
DI float opq_f(float c) { asm volatile("" : "+s"(c)); return c; }
#define PHASE_IDS const int lane = opq_lane(), wave = F.wave, tid = wave * 64 + lane, G = gridDim.x, bid = opq_bid(), gw = bid * NWAVES + wave, NGW = G * NWAVES; (void)lane; (void)gw; (void)NGW; (void)G; (void)bid; (void)tid;
template <class T> DI T* wsp(const Frame& F, size_t off) { unsigned o = (unsigned)off; asm volatile("" : "+s"(o)); return (T*)(F.ws + o); }
DI const float* inp(const Frame& F, int i) { (void)F; int k = i; asm volatile("" : "+s"(k));
    const __attribute__((address_space(4))) unsigned long long* t = (const __attribute__((address_space(4))) unsigned long long*)__builtin_amdgcn_kernarg_segment_ptr(); return (const float*)t[k]; }
struct TrDesc { const float* W; h16* WT; int N, ldd, w13add, k0, n0; };
DI void tr_load(const TrDesc& d, int lane, f32x4 (&v)[8]) { const int rl = lane >> 3, c4 = lane & 7;
#pragma unroll
    for (int i = 0; i < 8; ++i) v[i] = *(const f32x4*)(d.W + (size_t)(d.k0 + rl + 8 * i) * d.N + d.n0 + 4 * c4); }
DI void tr_store(const TrDesc& d, int lane, const f32x4 (&v)[8], LAS float* scr) { const int rl = lane >> 3, c4 = lane & 7;
#pragma unroll
    for (int i = 0; i < 8; ++i)
#pragma unroll
        for (int e = 0; e < 4; ++e) scr[(4 * c4 + e) * 65 + rl + 8 * i] = v[i][e];
    asm volatile("s_waitcnt lgkmcnt(0)" ::: "memory");
    const int c = lane & 7;
#pragma unroll
    for (int j = 0; j < 4; ++j) { const int n = (lane >> 3) + 8 * j; const LAS float* sp = scr + n * 65 + 8 * c; const int nn = d.n0 + n;
        const int row = d.w13add < 0 ? nn : 256 * (nn >> 7) + (nn & 127) + d.w13add;
        u32x4 o; o.x = pkh(sp[0], sp[1]); o.y = pkh(sp[2], sp[3]); o.z = pkh(sp[4], sp[5]); o.w = pkh(sp[6], sp[7]);
        *(u32x4*)(d.WT + (size_t)row * d.ldd + d.k0 + 8 * c) = o; }
    asm volatile("s_waitcnt lgkmcnt(0)" ::: "memory");
}
DI void cis_turns(double turns, float& c, float& s) { const double fr = turns - __builtin_rint(turns); const float f = (float)fr; c = __builtin_amdgcn_cosf(f); s = __builtin_amdgcn_sinf(f); }
struct S5Par { float ar, ai, dt; };
DI void s5_lampow(const S5Par& p, int tau, float& lr, float& li) {
    const float mag = __expf(p.ar * p.dt * (float)tau);
    float c, s; cis_turns((double)p.ai * (double)p.dt * (double)tau * 0.15915494309189535, c, s);
    lr = mag * c; li = mag * s;
}
DI void s5_z(const S5Par& p, float& zr, float& zi) {
    float lr, li; s5_lampow(p, 1, lr, li);
    const float rden = __builtin_amdgcn_rcpf(p.ar * p.ar + p.ai * p.ai);
    zr = ((lr - 1.f) * p.ar + li * p.ai) * rden; zi = (li * p.ar - (lr - 1.f) * p.ai) * rden;
}

DI void s5_pow_tables(const Frame& F, int l) { PHASE_IDS
    const float* are = inp(F, I_S5ARE) + l * 2048; const float* aim = inp(F, I_S5AIM) + l * 2048; const float* ldt = inp(F, I_S5LDT) + l * 32;
    const float* bre = inp(F, I_S5BRE) + (size_t)l * 32768; const float* bim = inp(F, I_S5BIM) + (size_t)l * 32768;
    float* LPW = wsp<float>(F, WS_LPW); float* BBR = wsp<float>(F, WS_BBR);
    for (int i = bid * 512 + tid; i < 2048 * 33; i += G * 512) { const int gp = i / 33, d = i - gp * 33; S5Par sp{are[gp], aim[gp], __expf(ldt[gp >> 6])}; float lr, li; s5_lampow(sp, d, lr, li); LPW[2 * i] = lr; LPW[2 * i + 1] = li; }
    for (int i = bid * 512 + tid; i < 2048 * 16; i += G * 512) { const int gp = i >> 4; S5Par sp{are[gp], aim[gp], __expf(ldt[gp >> 6])}; float zr, zi; s5_z(sp, zr, zi);
        const float br = bre[i], bi = bim[i]; BBR[2 * i] = zr * br - zi * bi; BBR[2 * i + 1] = zr * bi + zi * br; }
}
DI void convert_weights(const Frame& F, int l, int parts, int ws, int nwb, int scr_off) { PHASE_IDS
    const int gwp = bid * nwb + ws, NWP = G * nwb;
    LAS float* scr = (LAS float*)(F.lds + scr_off);
    constexpr int I_A = (DM / 64) * (NIN / 32), I_B = (DM / 64) * (DM / 32), I_C1 = (DM / 64) * (DFF / 32), I_D = (DFF / 64) * (DM / 32), I_E = (DG / 64) * (DG / 32);
    const int it_lo = (parts & 1) ? 0 : I_A, it_hi = (parts & 2) ? I_A + I_B + 2 * I_C1 + I_D + I_E : I_A;
#define TR_DESC(d, it) do { int r = (it); \
        if (r < I_A) { d.W = inp(F, I_WIN) + (size_t)l * DM * NIN; d.WT = wsp<h16>(F, WS_WIN); d.N = NIN; d.ldd = DM; d.w13add = -1; } \
        else if ((r -= I_A) < I_B) { d.W = inp(F, I_WOUT) + (size_t)l * DM * DM; d.WT = wsp<h16>(F, WS_WOUT); d.N = DM; d.ldd = DM; d.w13add = -1; } \
        else if ((r -= I_B) < I_C1) { d.W = inp(F, I_FW1) + (size_t)l * DM * DFF; d.WT = wsp<h16>(F, WS_W13); d.N = DFF; d.ldd = DM; d.w13add = 0; } \
        else if ((r -= I_C1) < I_C1) { d.W = inp(F, I_FW3) + (size_t)l * DM * DFF; d.WT = wsp<h16>(F, WS_W13); d.N = DFF; d.ldd = DM; d.w13add = 128; } \
        else if ((r -= I_C1) < I_D) { d.W = inp(F, I_FW2) + (size_t)l * DFF * DM; d.WT = wsp<h16>(F, WS_W2); d.N = DM; d.ldd = DFF; d.w13add = -1; } \
        else { r -= I_D; d.W = inp(F, I_GLUW) + (size_t)l * DG * DG; d.WT = wsp<h16>(F, WS_GLU); d.N = DG; d.ldd = DG; d.w13add = -1; } \
        const int nblk = d.N / 32; d.k0 = 64 * (r / nblk); d.n0 = 32 * (r % nblk); } while (0)
    if (parts & 3) { int it = it_lo + gwp; TrDesc dA, dB; f32x4 vA[8], vB[8];
        if (it < it_hi) { TR_DESC(dA, it); tr_load(dA, lane, vA); }
        while (it < it_hi) {
            const int it2 = it + NWP; if (it2 < it_hi) { TR_DESC(dB, it2); tr_load(dB, lane, vB); }
            tr_store(dA, lane, vA, scr);
            if (it2 >= it_hi) break;
            const int it3 = it2 + NWP; if (it3 < it_hi) { TR_DESC(dA, it3); tr_load(dA, lane, vA); }
            tr_store(dB, lane, vB, scr);
            it = it3; } }
#undef TR_DESC
    if (!(parts & 4)) return;
    const size_t gt = (size_t)gwp * 64 + lane, GT = (size_t)NWP * 64;
    { h16* LRT = wsp<h16>(F, WS_LRT); const float* w2 = inp(F, I_RWW2) + (size_t)l * 64 * DG; const float* a2 = inp(F, I_RWA2) + (size_t)l * 64 * DG; const float* g2 = inp(F, I_RWG2) + (size_t)l * 128 * DG;
        for (size_t i = gt; i < (size_t)1536 * 256; i += GT) { const int n = (int)(i >> 8), k = (int)(i & 255); float v = 0.f;
            if (n < 512) { if (k < 64) v = w2[k * DG + n]; }
            else if (n < 1024) { if (k >= 64 && k < 128) v = a2[(k - 64) * DG + (n - 512)]; }
            else { if (k >= 128) v = g2[(k - 128) * DG + (n - 1024)]; }
            LRT[i] = (h16)v; } }
    const float* cre = inp(F, I_S5CRE) + (size_t)l * 32768; const float* cim = inp(F, I_S5CIM) + (size_t)l * 32768;
    const float* LPW = wsp<float>(F, WS_LPW); const float* BBR = wsp<float>(F, WS_BBR);
    h16* T3 = wsp<h16>(F, WS_S5T3); h16* T1 = wsp<h16>(F, WS_S5T1);
    for (int un = gwp; un < 32 * 16 * 8; un += NWP) { const int g = un >> 7, c = (un >> 3) & 15, cp = 2 * (un & 7) + (lane >> 5), d = lane & 31; float kv = 0.f;
#pragma unroll 16
        for (int p = 0; p < 64; ++p) { const f32x2 lp = *(const f32x2*)(LPW + ((size_t)(g * 64 + p) * 33 + d) * 2), bb = *(const f32x2*)(BBR + ((size_t)(g * 64 + p) * 16 + cp) * 2);
            const float mr = lp.x * bb.x - lp.y * bb.y, mi = lp.x * bb.y + lp.y * bb.x;
            kv += cre[(g * 16 + c) * 64 + p] * mr - cim[(g * 16 + c) * 64 + p] * mi; }
        const h16 hv = (h16)kv;
        for (int t = 0; t < 32; ++t) { h16* rowp = T3 + ((size_t)g * 512 + t * 16 + c) * S5K3 + cp;
            if (t - d >= 0) rowp[(t - d) * 16] = hv;
            if (d > 0 && t + d < 32) rowp[(t + d) * 16] = (h16)0.f; }
    }
    for (size_t i0 = gt; i0 < (size_t)32 * 512 * 128; i0 += 4 * GT) { f32x2 lp[4]; float cr[4], ci[4];
#pragma unroll
        for (int u = 0; u < 4; ++u) { const size_t i = i0 + u * GT; const int n = (int)(i & 127), tc = (int)((i >> 7) & 511), g = (int)(i >> 16) & 31; const int t = tc >> 4, c = tc & 15, p = n & 63;
            lp[u] = *(const f32x2*)(LPW + ((size_t)(g * 64 + p) * 33 + t + 1) * 2); cr[u] = cre[(g * 16 + c) * 64 + p]; ci[u] = cim[(g * 16 + c) * 64 + p]; }
#pragma unroll
        for (int u = 0; u < 4; ++u) { const size_t i = i0 + u * GT; if (i < (size_t)32 * 512 * 128) { const int n = (int)(i & 127), tc = (int)((i >> 7) & 511), g = (int)(i >> 16);
            const float v = n < 64 ? (cr[u] * lp[u].x - ci[u] * lp[u].y) : -(cr[u] * lp[u].y + ci[u] * lp[u].x);
            T3[((size_t)g * 512 + tc) * S5K3 + 512 + n] = (h16)v; } } }
    for (size_t i0 = gt; i0 < (size_t)32 * 256 * 512; i0 += 4 * GT) { f32x2 lp[4], bb[4];
#pragma unroll
        for (int u = 0; u < 4; ++u) { const size_t i = i0 + u * GT; const int sc = (int)(i & 511), n = (int)((i >> 9) & 255), g = (int)(i >> 17) & 31; const int p = n & 63, s2 = sc >> 4, c = sc & 15;
            lp[u] = *(const f32x2*)(LPW + ((size_t)(g * 64 + p) * 33 + 31 - s2) * 2); bb[u] = *(const f32x2*)(BBR + ((size_t)(g * 64 + p) * 16 + c) * 2); }
#pragma unroll
        for (int u = 0; u < 4; ++u) { const size_t i = i0 + u * GT; if (i < (size_t)32 * 256 * 512) { const int n = (int)((i >> 9) & 255);
            const float v = n >= 128 ? 0.f : (n < 64 ? (lp[u].x * bb[u].x - lp[u].y * bb[u].y) : (lp[u].x * bb[u].y + lp[u].y * bb[u].x));
            T1[i] = (h16)v; } } }
}

DI void p0_mod(const Frame& F) { PHASE_IDS
    LAS float* cact = (LAS float*)F.lds;
    LAS float* red = (LAS float*)(F.lds + 65536);
    for (int i = tid; i < BATCH * DM; i += 512) cact[i] = siluf_(inp(F, I_C)[i]);
    __syncthreads();
    float* MOD = wsp<float>(F, WS_MOD);
    const int ks = tid >> 6, col = tid & 63;
    for (int un = bid; un < DEPTH * (MODW / 64); un += G) { const int l = un / (MODW / 64), cb = un % (MODW / 64);
        const float* w = inp(F, I_ADAW) + (size_t)l * DM * MODW + cb * 64 + col; float a[8] = {0, 0, 0, 0, 0, 0, 0, 0};
        for (int k = ks * 256; k < ks * 256 + 256; ++k) { const float wv = w[(size_t)k * MODW];
#pragma unroll
            for (int b = 0; b < 8; ++b) a[b] += cact[b * DM + k] * wv; }
#pragma unroll
        for (int b = 0; b < 8; ++b) red[(ks * 8 + b) * 64 + col] = a[b];
        __syncthreads();
        { const int b = tid >> 6; float s = 0.f;
#pragma unroll
            for (int k2 = 0; k2 < 8; ++k2) s += red[(k2 * 8 + b) * 64 + col];
            MOD[((size_t)l * BATCH + b) * MODW + cb * 64 + col] = s + inp(F, I_ADAB)[l * MODW + cb * 64 + col]; }
        __syncthreads();
    }
    if (bid == 0) { float* LB = wsp<float>(F, WS_LB); const int c = tid; const float* lg = inp(F, I_HGLB);
        const float v0 = lg[c], v1 = lg[512 + c], v2 = lg[1024 + c], v3 = lg[1536 + c]; const float mx = fmaxf(fmaxf(v0, v1), fmaxf(v2, v3));
        const float e0 = __expf(v0 - mx), e1 = __expf(v1 - mx), e2 = __expf(v2 - mx), e3 = __expf(v3 - mx), inv = __builtin_amdgcn_rcpf(e0 + e1 + e2 + e3);
        LB[c] = 0.f; LB[512 + c] = e1 * inv; LB[1024 + c] = (e1 + e2) * inv; LB[1536 + c] = (e1 + e2 + e3) * inv; }
    __syncthreads();
}
DI void modulate_rows(const Frame& F, const float* x, const float* modl, int shift_idx, h16* H) { PHASE_IDS
    for (int row = gw; row < M; row += NGW) { const int b = row >> 12; const float* sh = modl + (size_t)b * MODW + shift_idx * DM; const float* sc = sh + DM;
#pragma unroll
        for (int j = 0; j < 4; ++j) { const int c = j * 512 + lane * 8; const f32x4 x0 = *(const f32x4*)(x + (size_t)row * DM + c), x1 = *(const f32x4*)(x + (size_t)row * DM + c + 4);
            const f32x4 s0 = *(const f32x4*)(sc + c), s1 = *(const f32x4*)(sc + c + 4), h0 = *(const f32x4*)(sh + c), h1 = *(const f32x4*)(sh + c + 4);
            const f32x4 y0 = x0 * (1.f + s0) + h0, y1 = x1 * (1.f + s1) + h1;
            u32x4 w; w.x = pkh(y0[0], y0[1]); w.y = pkh(y0[2], y0[3]); w.z = pkh(y1[0], y1[1]); w.w = pkh(y1[2], y1[3]);
            *(u32x4*)(H + (size_t)row * DM + c) = w; } }
}
DI void ln_rows(const Frame& F, const float* xi, float* xo, const float* g, const float* bta, const float* modn, int shift_idx, h16* H, float* stat) { PHASE_IDS
    for (int rb = gw * 16; rb < M; rb += NGW * 16) { const int b = rb >> 12;
        f32x4 Gp[8], Bp[8];
#pragma unroll
        for (int j = 0; j < 8; ++j) { const int c = j * 256 + lane * 4; const f32x4 gv = *(const f32x4*)(g + c), bv = *(const f32x4*)(bta + c);
            if (H) { const float* sh = modn + (size_t)b * MODW + shift_idx * DM; const f32x4 sc1 = 1.f + *(const f32x4*)(sh + DM + c); Gp[j] = gv * sc1; Bp[j] = bv * sc1 + *(const f32x4*)(sh + c); }
            else { Gp[j] = gv; Bp[j] = bv; } }
        for (int r2 = 0; r2 < 16; r2 += 2) { f32x4 v[2][8];
#pragma unroll
            for (int u = 0; u < 2; ++u)
#pragma unroll
                for (int j = 0; j < 8; ++j) v[u][j] = *(const f32x4*)(xi + (size_t)(rb + r2 + u) * DM + j * 256 + lane * 4);
            __builtin_amdgcn_sched_barrier(0);
#pragma unroll
            for (int u = 0; u < 2; ++u) { const int row = rb + r2 + u; float s = 0.f;
#pragma unroll
                for (int j = 0; j < 8; ++j) s += (v[u][j][0] + v[u][j][1]) + (v[u][j][2] + v[u][j][3]);
                const float mean = wave_sum(s) * (1.f / DM); float q = 0.f;
#pragma unroll
                for (int j = 0; j < 8; ++j) { v[u][j] = v[u][j] - mean; q += (v[u][j][0] * v[u][j][0] + v[u][j][1] * v[u][j][1]) + (v[u][j][2] * v[u][j][2] + v[u][j][3] * v[u][j][3]); }
                const float rstd = rsqrtf_(wave_sum(q) * (1.f / DM) + opq_f(LN_EPS));
                if (stat && lane == 0) *(f32x2*)(stat + 2 * (size_t)row) = (f32x2){mean, rstd};
#pragma unroll
                for (int j = 0; j < 8; ++j) { const int c = j * 256 + lane * 4; const f32x4 y = v[u][j] * rstd * Gp[j] + Bp[j];
                    if (H) { u32x2 w; w.x = pkh(y[0], y[1]); w.y = pkh(y[2], y[3]); *(u32x2*)(H + (size_t)row * DM + c) = w; }
                    else *(f32x4*)(xo + (size_t)row * DM + c) = y; } } }
    }
}

DI void prep_rows(const Frame& F, int l) { PHASE_IDS
    const h16* P = wsp<h16>(F, WS_PROJ); h16* RWA = wsp<h16>(F, WS_RWA);
    const float* mu = inp(F, I_RWMU) + l * 1792;
    float mu4[4];
#pragma unroll
    for (int j = 0; j < 4; ++j) mu4[j] = mu[1536 + 4 * lane + j];
    for (int row0 = gw; row0 < M; row0 += 4 * NGW) { half4 cur[4], prv[4];
#pragma unroll
        for (int u = 0; u < 4; ++u) { const int row = row0 + u * NGW; const int rowc = row < M ? row : M - 1; const int t = rowc & (SEQ - 1); const h16* pr = P + (size_t)rowc * NIN;
            cur[u] = *(const half4*)(pr + RWOFF + 1536 + 4 * lane); prv[u] = *(const half4*)(pr - (t > 0 ? NIN : 0) + RWOFF + 1536 + 4 * lane); if (t == 0) prv[u] = (half4){0, 0, 0, 0}; }
#pragma unroll
        for (int u = 0; u < 4; ++u) { const int row = row0 + u * NGW; if (row < M) { float o[4];
#pragma unroll
            for (int j = 0; j < 4; ++j) { const float cv = (float)cur[u][j], sv = cv + mu4[j] * ((float)prv[u][j] - cv); o[j] = lane < 16 ? tanhf_(sv) : (lane < 32 ? sv : sigmoidf_(sv)); }
            u32x2 w; w.x = pkh(o[0], o[1]); w.y = pkh(o[2], o[3]); *(u32x2*)(RWA + (size_t)row * 256 + 4 * lane) = w; } }
    }
}
constexpr int RR_KH = 0, RR_RH = 2304, RR_BT = 4608, RR_KT = 6656, RR_VV = 8704, RR_TT = 10752, RR_A3 = 11264, RR_A2 = 11776, RR_A4 = 12288, RR_GL = 12800, RR_BYTES = 13312, RR_P = 72;
DI float wave_sum_all(float v) { v = sum16(v);
    const int iv = __builtin_bit_cast(int, v);
    return (__builtin_bit_cast(float, __builtin_amdgcn_readlane(iv, 0)) + __builtin_bit_cast(float, __builtin_amdgcn_readlane(iv, 16))) + (__builtin_bit_cast(float, __builtin_amdgcn_readlane(iv, 32)) + __builtin_bit_cast(float, __builtin_amdgcn_readlane(iv, 48))); }
DI void rwkv_chunk_prep(const Frame& F, int l) { PHASE_IDS
    const h16* P = wsp<h16>(F, WS_PROJ); const h16* LR = wsp<h16>(F, WS_LR16); unsigned char* REC = wsp<unsigned char>(F, WS_RWREC); float* BON = wsp<float>(F, WS_RWBON);
    LAS unsigned short* L = (LAS unsigned short*)(F.lds + wave * 16384);
    LAS float* A1L = (LAS float*)(F.lds + wave * 16384 + 4 * 16 * RR_P * 2);
    const float* mu = inp(F, I_RWMU) + l * 1792;
    const int k = lane, rr = lane & 15, q = lane >> 4;
    const int kperm = (k & 32) + 8 * ((k >> 2) & 3) + 4 * ((k >> 4) & 1) + (k & 3);
    int hprev = -1; float mur = 0.f, muk = 0.f, muv = 0.f, kk_ = 0.f, ka_ = 0.f, rk_ = 0.f, w0_ = 0.f, a0_ = 0.f;
    for (int cu = gw; cu < BATCH * 8 * 256; cu += NGW) { const int c = cu & 255, bh = cu >> 8, b = bh >> 3, h = bh & 7, col = h * 64 + k;
        const size_t t0 = (size_t)b * SEQ + 16 * c; unsigned char* rec = REC + (size_t)cu * RR_BYTES;
        if (h != hprev) { hprev = h;
            mur = mu[col]; muk = mu[512 + col]; muv = mu[1024 + col]; kk_ = inp(F, I_RWKK)[l * DG + col]; ka_ = inp(F, I_RWKA)[l * DG + col]; rk_ = inp(F, I_RWRK)[l * DG + col];
            w0_ = inp(F, I_RWW0)[l * DG + col]; a0_ = inp(F, I_RWA0)[l * DG + col]; }
        float rp = 0.f, kp_ = 0.f, vp = 0.f;
        if (c > 0) { const h16* pp = P + (t0 - 1) * NIN + RWOFF + col; rp = (float)pp[0]; kp_ = (float)pp[512]; vp = (float)pp[1024]; }
        float G = 1.f, bcv[16], kcv[16];
        h16 rin[16], kin[16], vin[16], zwin[16], zain[16];
#pragma unroll
        for (int jj = 0; jj < 16; ++jj) { const h16* pr = P + (t0 + jj) * NIN + RWOFF + col; rin[jj] = pr[0]; kin[jj] = pr[512]; vin[jj] = pr[1024]; zwin[jj] = LR[(t0 + jj) * 1536 + col]; zain[jj] = LR[(t0 + jj) * 1536 + 512 + col]; }
        __builtin_amdgcn_sched_barrier(0);
#pragma unroll
        for (int jj = 0; jj < 16; ++jj) { const float rc = (float)rin[jj], kc = (float)kin[jj], vc = (float)vin[jj];
            const float r = rc + mur * (rp - rc), kx = kc + muk * (kp_ - kc), vx = vc + muv * (vp - vc); rp = rc; kp_ = kc; vp = vc;
            const float a = sigmoidf_((float)zain[jj] + a0_), wd = __expf(-0.6065306597126334f * sigmoidf_((float)zwin[jj] + w0_));
            const float kkr = kx * kk_; const float n2 = wave_sum_all(kkr * kkr); const float kap = kkr * rsqrtf_(fmaxf(n2, 1e-24f));
            const float kpr = kx * (1.f + (a - 1.f) * ka_); const float bs = wave_sum_all(r * kpr * rk_);
            if (lane == 0) BON[(t0 + jj) * 8 + h] = bs;
            const float Gm = G; G *= wd; const float rg = __builtin_amdgcn_rcpf(G);
            const unsigned short khb = f2bf(kap * Gm), rhb = f2bf(r * G); bcv[jj] = kap * a * rg; kcv[jj] = kpr * rg;
            *(unsigned short*)(rec + RR_KH + (jj * RR_P + kperm) * 2) = khb; *(unsigned short*)(rec + RR_RH + (jj * RR_P + kperm) * 2) = rhb;
            *(unsigned short*)(rec + RR_VV + (jj * 64 + k) * 2) = f2bf(vx);
            L[jj * RR_P + k] = khb; L[(16 + jj) * RR_P + k] = rhb; L[(32 + jj) * RR_P + k] = f2bf(bcv[jj]); L[(48 + jj) * RR_P + k] = f2bf(kcv[jj]); }
        { u32x4 b0, b1, k0, k1;
#define PK2(x, y) ((unsigned)f2bf(x) | ((unsigned)f2bf(y) << 16))
            b0.x = PK2(-bcv[0], -bcv[1]); b0.y = PK2(-bcv[2], -bcv[3]); b0.z = PK2(-bcv[4], -bcv[5]); b0.w = PK2(-bcv[6], -bcv[7]); b1.x = PK2(-bcv[8], -bcv[9]); b1.y = PK2(-bcv[10], -bcv[11]); b1.z = PK2(-bcv[12], -bcv[13]); b1.w = PK2(-bcv[14], -bcv[15]);
            k0.x = PK2(kcv[0], kcv[1]); k0.y = PK2(kcv[2], kcv[3]); k0.z = PK2(kcv[4], kcv[5]); k0.w = PK2(kcv[6], kcv[7]); k1.x = PK2(kcv[8], kcv[9]); k1.y = PK2(kcv[10], kcv[11]); k1.z = PK2(kcv[12], kcv[13]); k1.w = PK2(kcv[14], kcv[15]);
            *(u32x4*)(rec + RR_BT + k * 32) = b0; *(u32x4*)(rec + RR_BT + k * 32 + 16) = b1; *(u32x4*)(rec + RR_KT + k * 32) = k0; *(u32x4*)(rec + RR_KT + k * 32 + 16) = k1;
            *(float*)(rec + RR_GL + k * 4) = G; }
        asm volatile("s_waitcnt lgkmcnt(0)" ::: "memory");
        f32x4 A1 = {0.f, 0.f, 0.f, 0.f}, A2 = A1, A3 = A1, A4 = A1;
#pragma unroll
        for (int ks = 0; ks < 2; ++ks) { const int off = rr * RR_P + 32 * ks + 8 * q;
            const bf16x8 fkh = *(const LAS bf16x8*)(L + off), frh = *(const LAS bf16x8*)(L + 16 * RR_P + off), fbc = *(const LAS bf16x8*)(L + 32 * RR_P + off), fkc = *(const LAS bf16x8*)(L + 48 * RR_P + off);
            A1 = __builtin_amdgcn_mfma_f32_16x16x32_bf16(fbc, fkh, A1, 0, 0, 0); A2 = __builtin_amdgcn_mfma_f32_16x16x32_bf16(fkc, fkh, A2, 0, 0, 0);
            A3 = __builtin_amdgcn_mfma_f32_16x16x32_bf16(fbc, frh, A3, 0, 0, 0); A4 = __builtin_amdgcn_mfma_f32_16x16x32_bf16(fkc, frh, A4, 0, 0, 0); }
        { u32x2 w3, w2, w4; float m3[4], m2[4], m4[4];
#pragma unroll
            for (int i2 = 0; i2 < 4; ++i2) { const int sidx = 4 * q + i2; const bool lt = sidx < rr, le = sidx <= rr;
                A1L[sidx * 16 + rr] = lt ? A1[i2] : 0.f; m2[i2] = lt ? A2[i2] : 0.f; m3[i2] = le ? -A3[i2] : 0.f; m4[i2] = le ? A4[i2] : 0.f; }
            w3.x = PK2(m3[0], m3[1]); w3.y = PK2(m3[2], m3[3]); w2.x = PK2(m2[0], m2[1]); w2.y = PK2(m2[2], m2[3]); w4.x = PK2(m4[0], m4[1]); w4.y = PK2(m4[2], m4[3]);
            *(u32x2*)(rec + RR_A3 + (rr * 16 + 4 * q) * 2) = w3; *(u32x2*)(rec + RR_A2 + (rr * 16 + 4 * q) * 2) = w2; *(u32x2*)(rec + RR_A4 + (rr * 16 + 4 * q) * 2) = w4; }
        asm volatile("s_waitcnt lgkmcnt(0)" ::: "memory");
        { float x[16];
#pragma unroll
            for (int sidx = 15; sidx >= 0; --sidx) { float acc = (sidx == rr) ? 1.f : 0.f;
#pragma unroll
                for (int s2 = sidx + 1; s2 < 16; ++s2) acc -= A1L[sidx * 16 + s2] * x[s2];
                x[sidx] = acc; }
            if (lane < 16) { u32x4 t0v, t1v; t0v.x = PK2(x[0], x[1]); t0v.y = PK2(x[2], x[3]); t0v.z = PK2(x[4], x[5]); t0v.w = PK2(x[6], x[7]); t1v.x = PK2(x[8], x[9]); t1v.y = PK2(x[10], x[11]); t1v.z = PK2(x[12], x[13]); t1v.w = PK2(x[14], x[15]);
                *(u32x4*)(rec + RR_TT + lane * 32) = t0v; *(u32x4*)(rec + RR_TT + lane * 32 + 16) = t1v; } }
#undef PK2
        asm volatile("s_waitcnt lgkmcnt(0)" ::: "memory");
    }
}
DI void s5_chunk_scan(const Frame& F, int l) { PHASE_IDS
    const float* HL = wsp<float>(F, WS_HLOC); h16* UG = wsp<h16>(F, WS_UG);
    const float* are = inp(F, I_S5ARE) + l * 2048; const float* aim = inp(F, I_S5AIM) + l * 2048; const float* ldt = inp(F, I_S5LDT) + l * 32;
    for (int un = gw; un < 32 * BATCH; un += NGW) { const int g = un >> 3, b = un & 7, p = lane;
        S5Par sp{are[g * 64 + p], aim[g * 64 + p], __expf(ldt[g])}; float Lr, Li; s5_lampow(sp, S5L, Lr, Li);
        float hr = 0.f, hi = 0.f; const size_t base = (size_t)g * S5NC + b * 128;
        for (int c0 = 0; c0 < 128; c0 += 32) { float xr[32], xi[32];
#pragma unroll
            for (int j = 0; j < 32; ++j) { xr[j] = HL[(base + c0 + j) * 128 + p]; xi[j] = HL[(base + c0 + j) * 128 + 64 + p]; }
            __builtin_amdgcn_sched_barrier(0);
#pragma unroll
            for (int j = 0; j < 32; ++j) { h16* dst = UG + (base + c0 + j) * S5K3 + 512; dst[p] = (h16)hr; dst[64 + p] = (h16)hi;
                const float nr = Lr * hr - Li * hi + xr[j], ni = Lr * hi + Li * hr + xi[j]; hr = nr; hi = ni; } }
    }
}

typedef float f32x16 __attribute__((ext_vector_type(16)));
DI void attention_units(const Frame& F, int ws, int nwb) { PHASE_IDS
    const int NWP = G * nwb, gwp = NWP - 1 - (bid * nwb + ws);
    const h16* P = wsp<h16>(F, WS_PROJ); h16* MIX = wsp<h16>(F, WS_H16);
    const int r = lane & 31, hh = lane >> 5;
    for (int un = gwp; un < BATCH * 4 * (SEQ / 32); un += NWP) { const int qt = un & 127, bh = un >> 7, b = bh >> 2, h = bh & 3, t0 = 32 * qt;
        const size_t tokb = (size_t)b * SEQ;
        half8 qf[8];
#pragma unroll
        for (int s8 = 0; s8 < 8; ++s8) qf[s8] = *(const half8*)(P + (tokb + t0 + r) * NIN + 2560 + h * 128 + 16 * s8 + 8 * hh);
        f32x16 oacc[4];
#pragma unroll
        for (int mt = 0; mt < 4; ++mt)
#pragma unroll
            for (int i2 = 0; i2 < 16; ++i2) oacc[mt][i2] = 0.f;
        float run = 0.f;
        for (int k0 = t0; k0 >= 0; k0 -= 32) {
            f32x16 sacc;
#pragma unroll
            for (int i2 = 0; i2 < 16; ++i2) sacc[i2] = 0.f;
            const h16* kr = P + (tokb + k0 + r) * NIN + 3072 + h * 128 + 8 * hh; const h16* vr = P + (tokb + k0 + 4 * hh) * NIN + 3584 + h * 128 + 4 * r;
            half8 kfa[8]; half4 vqa[16];
#pragma unroll
            for (int s8 = 0; s8 < 8; ++s8) kfa[s8] = *(const half8*)(kr + 16 * s8);
#pragma unroll
            for (int jj = 0; jj < 16; ++jj) vqa[jj] = *(const half4*)(vr + (size_t)(16 * (jj >> 3) + 8 * ((jj >> 2) & 1) + (jj & 3)) * NIN);
            __builtin_amdgcn_sched_barrier(0);
#pragma unroll
            for (int s8 = 0; s8 < 8; ++s8) sacc = __builtin_amdgcn_mfma_f32_32x32x16_f16(kfa[s8], qf[s8], sacc, 0, 0, 0);
            const bool diag = (k0 == t0);
            float ls[16], zz[16];
#pragma unroll
            for (int i2 = 0; i2 < 16; ++i2) { const int kc = (i2 & 3) + 8 * (i2 >> 2) + 4 * hh; const bool valid = !diag || (kc < r);
                zz[i2] = sacc[i2] * 0.08838834764831845f; ls[i2] = valid ? -softplusf_(zz[i2]) : 0.f; }
            float Gs[4], Ps[4];
#pragma unroll
            for (int g = 0; g < 4; ++g) { Gs[g] = (ls[4 * g] + ls[4 * g + 1]) + (ls[4 * g + 2] + ls[4 * g + 3]); Ps[g] = __shfl_xor(Gs[g], 32); }
            float later = 0.f, T[4];
#pragma unroll
            for (int g = 3; g >= 0; --g) { T[g] = later + (hh == 0 ? Ps[g] : 0.f); later += Gs[g] + Ps[g]; }
            half8 wf[2];
#pragma unroll
            for (int g = 0; g < 4; ++g) { float af[4]; af[3] = run + T[g]; af[2] = af[3] + ls[4 * g + 3]; af[1] = af[2] + ls[4 * g + 2]; af[0] = af[1] + ls[4 * g + 1];
#pragma unroll
                for (int e = 0; e < 4; ++e) { const int i2 = 4 * g + e; const int kc = (i2 & 3) + 8 * (i2 >> 2) + 4 * hh; const bool valid = !diag || (kc < r);
                    const float w = valid ? __expf(zz[i2] + ls[i2] + af[e]) : 0.f; wf[g >> 1][4 * (g & 1) + e] = (h16)w; } }
            run += later;
#pragma unroll
            for (int s2 = 0; s2 < 2; ++s2) { half8 vf[4];
#pragma unroll
                for (int jj = 0; jj < 8; ++jj) { const half4 v4 = vqa[8 * s2 + jj]; vf[0][jj] = v4[0]; vf[1][jj] = v4[1]; vf[2][jj] = v4[2]; vf[3][jj] = v4[3]; }
#pragma unroll
                for (int mt = 0; mt < 4; ++mt) oacc[mt] = __builtin_amdgcn_mfma_f32_32x32x16_f16(vf[mt], wf[s2], oacc[mt], 0, 0, 0); }
            if (__builtin_amdgcn_ballot_w64(run >= -110.f) == 0ull) break;
        }
        h16* orow = MIX + (tokb + t0 + r) * DM + 1024 + h * 128;
#pragma unroll
        for (int i2 = 0; i2 < 16; ++i2) { const int m = (i2 & 3) + 8 * (i2 >> 2) + 4 * hh; u32x2 w; w.x = pkh(oacc[0][i2], oacc[1][i2]); w.y = pkh(oacc[2][i2], oacc[3][i2]);
            *(u32x2*)(orow + 4 * m) = w; }
    }
}

typedef __bf16 bfv4 __attribute__((ext_vector_type(4)));
DI bf16x4 pack4bf(const f32x4 v) { return __builtin_bit_cast(bf16x4, __builtin_convertvector(v, bfv4)); }
DI bf16x8 cat8(const bf16x4 a, const bf16x4 b) { bf16x8 r; r[0] = a[0]; r[1] = a[1]; r[2] = a[2]; r[3] = a[3]; r[4] = b[0]; r[5] = b[1]; r[6] = b[2]; r[7] = b[3]; return r; }
constexpr int RW_NSLOT = 9, RW_SYNC_OFF = MISC_OFF + 128;
DI void rwkv_sync_zero(const Frame& F) { volatile LAS unsigned* sy = (volatile LAS unsigned*)(F.lds + RW_SYNC_OFF); if (F.wave == 0 && opq_lane() == 0) { sy[0] = 0u; sy[1] = 0u; sy[2] = 0u; } }
DI void rwkv_scan_loader(const Frame& F, int w) { PHASE_IDS
    volatile LAS unsigned* sy = (volatile LAS unsigned*)(F.lds + RW_SYNC_OFF);
    const unsigned ring = (unsigned)(size_t)F.lds;
    int ui = 0;
    for (int un = bid; un < 256; un += G, ++ui) { const int bh = un >> 2;
        const unsigned char* REC = wsp<unsigned char>(F, WS_RWREC) + (size_t)bh * 256 * RR_BYTES;
        for (int i2 = 0; i2 < 128; ++i2) { const int c = 2 * i2 + w, gc = ui * 256 + c;
            for (unsigned sp = 0; (int)(gc - (int)sy[2]) >= RW_NSLOT && sp < (1u << 22); ++sp) __builtin_amdgcn_s_sleep(2);
            const char* src = (const char*)(REC + (size_t)c * RR_BYTES); const unsigned dst = ring + (unsigned)((gc % RW_NSLOT) * RR_BYTES);
#pragma unroll
            for (int p = 0; p < 13; ++p) pg8::glds16_s(src + p * 1024, (unsigned)lane * 16u, dst + p * 1024u);
            if (i2 >= 3) { asm volatile("s_waitcnt vmcnt(39)" ::: "memory"); if (lane == 0) sy[w] = (unsigned)(ui * 128 + i2 - 2); }
        }
        asm volatile("s_waitcnt vmcnt(0)" ::: "memory"); if (lane == 0) sy[w] = (unsigned)(ui * 128 + 128);
    }
}
DI void rwkv_scan_consumer(const Frame& F) { PHASE_IDS
    volatile LAS unsigned* sy = (volatile LAS unsigned*)(F.lds + RW_SYNC_OFF);
    const int rr = lane & 15, q = lane >> 4; const int q1 = q & 1; const bool qlo = q < 2;
    const bf16x4 z4 = {0, 0, 0, 0}; const bf16x8 z8 = {0, 0, 0, 0, 0, 0, 0, 0};
    int ui = 0;
    for (int un = bid; un < 256; un += G, ++ui) { const int vq = un & 3, bh = un >> 2, b = bh >> 3, h = bh & 7;
        __attribute__((address_space(1))) h16* RAW = (__attribute__((address_space(1))) h16*)(wsp<h16>(F, WS_RWRAW) + (size_t)b * SEQ * DG + h * 64 + 16 * vq + rr);
        f32x4 ST[4];
#pragma unroll
        for (int kt = 0; kt < 4; ++kt) ST[kt] = (f32x4){0.f, 0.f, 0.f, 0.f};
        for (int c = 0; c < 256; ++c) { const int gc = ui * 256 + c; const unsigned need = (unsigned)(ui * 128 + (c >> 1) + 1);
            for (unsigned sp = 0; sy[c & 1] < need && sp < (1u << 22); ++sp) __builtin_amdgcn_s_sleep(1);
            const LAS unsigned char* sl = F.lds + (gc % RW_NSLOT) * RR_BYTES;
            bf16x8 khf[2], rhf[2], ktf[4], a2f, a4f, ttf, a3f, btf[4], vB; f32x4 gl[4];
#pragma unroll
            for (int ks = 0; ks < 2; ++ks) { khf[ks] = *(const LAS bf16x8*)(sl + RR_KH + (rr * RR_P + 32 * ks + 8 * q) * 2); rhf[ks] = *(const LAS bf16x8*)(sl + RR_RH + (rr * RR_P + 32 * ks + 8 * q) * 2); }
            a2f = *(const LAS bf16x8*)(sl + RR_A2 + (rr * 16 + 8 * q1) * 2); a4f = *(const LAS bf16x8*)(sl + RR_A4 + (rr * 16 + 8 * q1) * 2);
            ttf = cat8(*(const LAS bf16x4*)(sl + RR_TT + (rr * 16 + 4 * q) * 2), z4); a3f = cat8(*(const LAS bf16x4*)(sl + RR_A3 + (rr * 16 + 4 * q) * 2), z4);
#pragma unroll
            for (int kt = 0; kt < 4; ++kt) { btf[kt] = cat8(*(const LAS bf16x4*)(sl + RR_BT + ((16 * kt + rr) * 16 + 4 * q) * 2), z4);
                ktf[kt] = *(const LAS bf16x8*)(sl + RR_KT + ((16 * kt + rr) * 16 + 8 * q1) * 2); gl[kt] = *(const LAS f32x4*)(sl + RR_GL + (16 * kt + 4 * q) * 4); }
#pragma unroll
            for (int jj = 0; jj < 8; ++jj) vB[jj] = *(const LAS short*)(sl + RR_VV + ((8 * q1 + jj) * 64 + 16 * vq + rr) * 2);
            asm volatile("s_waitcnt lgkmcnt(0)" ::: "memory");
            __builtin_amdgcn_sched_barrier(0);
            if (lane == 0) sy[2] = (unsigned)(gc + 1);
            a2f = qlo ? a2f : z8; a4f = qlo ? a4f : z8; vB = qlo ? vB : z8;
#pragma unroll
            for (int kt = 0; kt < 4; ++kt) ktf[kt] = qlo ? ktf[kt] : z8;
            const bf16x8 sb0 = cat8(pack4bf(ST[0]), pack4bf(ST[1])), sb1 = cat8(pack4bf(ST[2]), pack4bf(ST[3]));
            f32x4 acc = {0.f, 0.f, 0.f, 0.f};
            acc = __builtin_amdgcn_mfma_f32_16x16x32_bf16(a2f, vB, acc, 0, 0, 0); acc = __builtin_amdgcn_mfma_f32_16x16x32_bf16(khf[0], sb0, acc, 0, 0, 0); acc = __builtin_amdgcn_mfma_f32_16x16x32_bf16(khf[1], sb1, acc, 0, 0, 0);
            const bf16x8 rB = cat8(pack4bf(acc), z4);
            f32x4 e = {0.f, 0.f, 0.f, 0.f}; e = __builtin_amdgcn_mfma_f32_16x16x32_bf16(ttf, rB, e, 0, 0, 0);
            const bf16x8 eB = cat8(pack4bf(e), z4);
            f32x4 o = {0.f, 0.f, 0.f, 0.f};
            o = __builtin_amdgcn_mfma_f32_16x16x32_bf16(a4f, vB, o, 0, 0, 0); o = __builtin_amdgcn_mfma_f32_16x16x32_bf16(rhf[0], sb0, o, 0, 0, 0); o = __builtin_amdgcn_mfma_f32_16x16x32_bf16(rhf[1], sb1, o, 0, 0, 0);
            o = __builtin_amdgcn_mfma_f32_16x16x32_bf16(a3f, eB, o, 0, 0, 0);
#pragma unroll
            for (int kt = 0; kt < 4; ++kt) { f32x4 t = __builtin_amdgcn_mfma_f32_16x16x32_bf16(btf[kt], eB, ST[kt], 0, 0, 0); t = __builtin_amdgcn_mfma_f32_16x16x32_bf16(ktf[kt], vB, t, 0, 0, 0); ST[kt] = t * gl[kt]; }
#pragma unroll
            for (int i2 = 0; i2 < 4; ++i2) RAW[(size_t)(16 * c + 4 * q + i2) * DG] = (h16)o[i2];
        }
    }
}
DI void hgrn_prep(const Frame& F, int l) { PHASE_IDS
    const h16* P = wsp<h16>(F, WS_PROJ); unsigned short* KT = wsp<unsigned short>(F, WS_HGK); unsigned short* QT = wsp<unsigned short>(F, WS_HGQ); float* HB = wsp<float>(F, WS_HGB);
    const float lbc = 1.f - wsp<float>(F, WS_LB)[l * 512 + tid];
    for (int un = bid; un < BATCH * 64; un += G) { const size_t tok0 = (size_t)un * 64;
        float B = 0.f, Bmid = 0.f;
        for (int th = 0; th < 64; th += 32) { h16 zin[32];
#pragma unroll
            for (int t = 0; t < 32; ++t) zin[t] = P[(tok0 + th + t) * NIN + 512 + tid];
            __builtin_amdgcn_sched_barrier(0);
#pragma unroll
            for (int t = 0; t < 32; ++t) { const float k = lbc * sigmoidf_(-(float)zin[t]); B += 0.6931471805599453f * __builtin_amdgcn_logf(1.f - k); if (th + t == 31) Bmid = B; } }
        HB[(size_t)un * 1024 + tid] = Bmid; HB[(size_t)un * 1024 + 512 + tid] = B;
        B = 0.f;
        for (int th = 0; th < 64; th += 32) { h16 zin[32], qin[32];
#pragma unroll
            for (int t = 0; t < 32; ++t) { zin[t] = P[(tok0 + th + t) * NIN + 512 + tid]; qin[t] = P[(tok0 + th + t) * NIN + tid]; }
            __builtin_amdgcn_sched_barrier(0);
#pragma unroll
            for (int t = 0; t < 32; ++t) { const float z = (float)zin[t], qv = (float)qin[t]; const float k = lbc * sigmoidf_(-z);
                B += 0.6931471805599453f * __builtin_amdgcn_logf(1.f - k);
                QT[(tok0 + th + t) * DG + tid] = f2bf(siluf_(qv) * __expf(fminf(B - Bmid, 80.f))); KT[(tok0 + th + t) * DG + tid] = f2bf(k * __expf(fminf(Bmid - B, 80.f))); } }
    }
}
DI void hgrn_loc_units(const Frame& F) { PHASE_IDS
    const h16* P = wsp<h16>(F, WS_PROJ); const unsigned short* KT = wsp<unsigned short>(F, WS_HGK); unsigned short* ST = wsp<unsigned short>(F, WS_HGST); const float* HB = wsp<float>(F, WS_HGB);
    const int r = lane & 31, hh = lane >> 5;
    for (int un = gw; un < BATCH * 4 * 64 * 4; un += NGW) { const int mt = un & 3, bhc = un >> 2, c = bhc & 63, bh = bhc >> 6, b = bh >> 2, h = bh & 3;
        const size_t tok0 = ((size_t)b * 64 + c) * 64;
        f32x16 acc[4];
#pragma unroll
        for (int nt = 0; nt < 4; ++nt)
#pragma unroll
            for (int i2 = 0; i2 < 16; ++i2) acc[nt][i2] = 0.f;
        h16 vraw[4][8]; bf16x4 kraw[4][8];
#pragma unroll
        for (int s4 = 0; s4 < 4; ++s4)
#pragma unroll
            for (int jj = 0; jj < 8; ++jj) { const size_t tk = tok0 + 16 * s4 + 8 * hh + jj; vraw[s4][jj] = P[tk * NIN + 1024 + h * 128 + 4 * r + mt]; kraw[s4][jj] = *(const bf16x4*)(KT + tk * DG + h * 128 + 4 * r); }
        const float* hb = HB + ((size_t)b * 64 + c) * 1024 + h * 128 + 4 * r; const f32x4 bm = *(const f32x4*)hb, bl = *(const f32x4*)(hb + 512);
        __builtin_amdgcn_sched_barrier(0);
        bf16x8 afa[4], bfa[4][4];
#pragma unroll
        for (int s4 = 0; s4 < 4; ++s4)
#pragma unroll
            for (int jj = 0; jj < 8; ++jj) { afa[s4][jj] = (short)f2bf((float)vraw[s4][jj]); const bf16x4 k4 = kraw[s4][jj]; bfa[s4][0][jj] = k4[0]; bfa[s4][1][jj] = k4[1]; bfa[s4][2][jj] = k4[2]; bfa[s4][3][jj] = k4[3]; }
#pragma unroll
        for (int s4 = 0; s4 < 4; ++s4)
#pragma unroll
            for (int nt = 0; nt < 4; ++nt) acc[nt] = __builtin_amdgcn_mfma_f32_32x32x16_bf16(afa[s4], bfa[s4][nt], acc[nt], 0, 0, 0);
        float e[4];
#pragma unroll
        for (int nt = 0; nt < 4; ++nt) e[nt] = __expf(bl[nt] - bm[nt]);
        unsigned short* st = ST + (size_t)bhc * 16384 + 4 * r;
#pragma unroll
        for (int i2 = 0; i2 < 16; ++i2) { const int v = 4 * ((i2 & 3) + 8 * (i2 >> 2) + 4 * hh) + mt;
            u32x2 w; w.x = (unsigned)f2bf(acc[0][i2] * e[0]) | ((unsigned)f2bf(acc[1][i2] * e[1]) << 16); w.y = (unsigned)f2bf(acc[2][i2] * e[2]) | ((unsigned)f2bf(acc[3][i2] * e[3]) << 16);
            *(u32x2*)(st + (size_t)v * 128) = w; }
    }
}
DI void hgrn_state_scan(const Frame& F) { PHASE_IDS
    unsigned short* ST = wsp<unsigned short>(F, WS_HGST); const float* HB = wsp<float>(F, WS_HGB);
    for (int e0 = bid * 512 + tid; e0 < 32 * 4096; e0 += G * 512) { const int bh = e0 >> 12, rem = e0 & 4095, v = rem >> 5, k4 = (rem & 31) * 4, b = bh >> 2, h = bh & 3;
        float s0 = 0.f, s1 = 0.f, s2 = 0.f, s3 = 0.f;
        unsigned short* st = ST + (size_t)bh * 64 * 16384 + (size_t)v * 128 + k4; const float* hb = HB + (size_t)b * 64 * 1024 + h * 128 + k4;
        for (int c0 = 0; c0 < 64; c0 += 8) { u32x2 wv[8]; f32x4 bmv[8], blv[8];
#pragma unroll
            for (int j = 0; j < 8; ++j) { wv[j] = *(const u32x2*)(st + (size_t)(c0 + j) * 16384); bmv[j] = *(const f32x4*)(hb + (size_t)(c0 + j) * 1024); blv[j] = *(const f32x4*)(hb + (size_t)(c0 + j) * 1024 + 512); }
            __builtin_amdgcn_sched_barrier(0);
#pragma unroll
            for (int j = 0; j < 8; ++j) { const u32x2 w = wv[j]; const f32x4 bm = bmv[j], bl = blv[j];
                u32x2 o; o.x = (unsigned)f2bf(s0 * __expf(bm[0])) | ((unsigned)f2bf(s1 * __expf(bm[1])) << 16); o.y = (unsigned)f2bf(s2 * __expf(bm[2])) | ((unsigned)f2bf(s3 * __expf(bm[3])) << 16);
                *(u32x2*)(st + (size_t)(c0 + j) * 16384) = o;
                s0 = s0 * __expf(bl[0]) + bf2f((unsigned short)(w.x & 0xffffu)); s1 = s1 * __expf(bl[1]) + bf2f((unsigned short)(w.x >> 16));
                s2 = s2 * __expf(bl[2]) + bf2f((unsigned short)(w.y & 0xffffu)); s3 = s3 * __expf(bl[3]) + bf2f((unsigned short)(w.y >> 16)); } }
    }
}
DI void hgrn_out_unit(const Frame& F, int un, const float* ng) { PHASE_IDS
    const h16* P = wsp<h16>(F, WS_PROJ); const unsigned short* KT = wsp<unsigned short>(F, WS_HGK); const unsigned short* QT = wsp<unsigned short>(F, WS_HGQ);
    const unsigned short* ST = wsp<unsigned short>(F, WS_HGST); h16* MIX = wsp<h16>(F, WS_H16);
    const int r = lane & 31, hh = lane >> 5;
    const int tt = un & 1, bhc = un >> 1, c = bhc & 63, bh = bhc >> 6, b = bh >> 2, h = bh & 3;
    const size_t tok0 = ((size_t)b * 64 + c) * 64, tq = tok0 + 32 * tt + r;
    bf16x8 qf[8];
#pragma unroll
    for (int s8 = 0; s8 < 8; ++s8) qf[s8] = *(const bf16x8*)(QT + tq * DG + h * 128 + 16 * s8 + 8 * hh);
    f32x16 oacc[4];
#pragma unroll
    for (int mt = 0; mt < 4; ++mt)
#pragma unroll
        for (int i2 = 0; i2 < 16; ++i2) oacc[mt][i2] = 0.f;
    const unsigned short* st = ST + (size_t)bhc * 16384 + (size_t)(4 * r) * 128 + 8 * hh;
#pragma unroll
    for (int s8h = 0; s8h < 8; s8h += 4) { bf16x8 sfa[4][4];
#pragma unroll
        for (int s8 = 0; s8 < 4; ++s8)
#pragma unroll
            for (int mt = 0; mt < 4; ++mt) sfa[s8][mt] = *(const bf16x8*)(st + mt * 128 + 16 * (s8h + s8));
        __builtin_amdgcn_sched_barrier(0);
#pragma unroll
        for (int s8 = 0; s8 < 4; ++s8)
#pragma unroll
            for (int mt = 0; mt < 4; ++mt) oacc[mt] = __builtin_amdgcn_mfma_f32_32x32x16_bf16(sfa[s8][mt], qf[s8h + s8], oacc[mt], 0, 0, 0); }
    for (int st2 = 0; st2 <= tt; ++st2) { f32x16 sacc;
#pragma unroll
        for (int i2 = 0; i2 < 16; ++i2) sacc[i2] = 0.f;
        const unsigned short* kr = KT + (tok0 + 32 * st2 + r) * DG + h * 128 + 8 * hh; const h16* vr = P + (tok0 + 32 * st2 + 4 * hh) * NIN + 1024 + h * 128 + 4 * r;
        bf16x8 kfa[8]; half4 vqa[16];
#pragma unroll
        for (int s8 = 0; s8 < 8; ++s8) kfa[s8] = *(const bf16x8*)(kr + 16 * s8);
#pragma unroll
        for (int jj = 0; jj < 16; ++jj) vqa[jj] = *(const half4*)(vr + (size_t)(16 * (jj >> 3) + 8 * ((jj >> 2) & 1) + (jj & 3)) * NIN);
        __builtin_amdgcn_sched_barrier(0);
#pragma unroll
        for (int s8 = 0; s8 < 8; ++s8) sacc = __builtin_amdgcn_mfma_f32_32x32x16_bf16(kfa[s8], qf[s8], sacc, 0, 0, 0);
        const bool diag = (st2 == tt); half8 wf[2];
#pragma unroll
        for (int i2 = 0; i2 < 16; ++i2) { const int kc = (i2 & 3) + 8 * (i2 >> 2) + 4 * hh; const bool valid = !diag || (kc <= r); wf[i2 >> 3][i2 & 7] = (h16)(valid ? sacc[i2] : 0.f); }
#pragma unroll
        for (int s2 = 0; s2 < 2; ++s2) { half8 vf[4];
#pragma unroll
            for (int jj = 0; jj < 8; ++jj) { const half4 v4 = vqa[8 * s2 + jj]; vf[0][jj] = v4[0]; vf[1][jj] = v4[1]; vf[2][jj] = v4[2]; vf[3][jj] = v4[3]; }
#pragma unroll
            for (int mt = 0; mt < 4; ++mt) oacc[mt] = __builtin_amdgcn_mfma_f32_32x32x16_f16(vf[mt], wf[s2], oacc[mt], 0, 0, 0); }
    }
    float q = 0.f;
#pragma unroll
    for (int mt = 0; mt < 4; ++mt)
#pragma unroll
        for (int i2 = 0; i2 < 16; ++i2) q += oacc[mt][i2] * oacc[mt][i2];
    q += __shfl_xor(q, 32);
    const float rr = rsqrtf_(q * (1.f / 128.f) + opq_f(RMS_EPS));
    const h16* gp = P + tq * NIN + 1536 + h * 128; h16* orow = MIX + tq * DM + h * 128;
    half4 g4a[16]; f32x4 n4a[16];
#pragma unroll
    for (int i2 = 0; i2 < 16; ++i2) { const int v0 = 4 * ((i2 & 3) + 8 * (i2 >> 2) + 4 * hh); g4a[i2] = *(const half4*)(gp + v0); n4a[i2] = *(const f32x4*)(ng + h * 128 + v0); }
#pragma unroll
    for (int i2 = 0; i2 < 16; ++i2) { const int v0 = 4 * ((i2 & 3) + 8 * (i2 >> 2) + 4 * hh);
        float o[4];
#pragma unroll
        for (int mt = 0; mt < 4; ++mt) o[mt] = oacc[mt][i2] * rr * n4a[i2][mt] * siluf_((float)g4a[i2][mt]);
        u32x2 w; w.x = pkh(o[0], o[1]); w.y = pkh(o[2], o[3]); *(u32x2*)(orow + v0) = w; }
}
DI void finalize_rows(const Frame& F, int l) { PHASE_IDS
    h16* MIX = wsp<h16>(F, WS_H16);
    const h16* RAW = wsp<h16>(F, WS_RWRAW); const unsigned char* REC = wsp<unsigned char>(F, WS_RWREC); const float* BON = wsp<float>(F, WS_RWBON); const h16* GG = wsp<h16>(F, WS_LR16);
    const int c0 = 8 * lane, hd = lane >> 3, kcol = c0 & 63;
    float gg[8], gb[8];
#pragma unroll
    for (int j = 0; j < 8; ++j) { gg[j] = inp(F, I_RWGNG)[l * DG + c0 + j]; gb[j] = inp(F, I_RWGNB)[l * DG + c0 + j]; }
    for (int row0 = gw; row0 < M; row0 += 2 * NGW) { half8 xr[2], gr[2]; u32x4 vr2[2]; float bsr[2];
#pragma unroll
        for (int u = 0; u < 2; ++u) { const int row = (row0 + u * NGW) < M ? (row0 + u * NGW) : M - 1; const int b = row >> 12, sq = row & (SEQ - 1);
            xr[u] = *(const half8*)(RAW + (size_t)row * DG + c0); gr[u] = *(const half8*)(GG + (size_t)row * 1536 + 1024 + c0);
            vr2[u] = *(const u32x4*)(REC + ((size_t)(b * 8 + hd) * 256 + (sq >> 4)) * RR_BYTES + RR_VV + ((sq & 15) * 64 + kcol) * 2); bsr[u] = BON[(size_t)row * 8 + hd]; }
#pragma unroll
        for (int u = 0; u < 2; ++u) { const int row = row0 + u * NGW; if (row < M) {
        float x[8], g[8]; h8_to_f(xr[u], x); h8_to_f(gr[u], g); const u32x4 vv = vr2[u]; const float bs = bsr[u];
        const float v[8] = {bf2f((unsigned short)(vv.x & 0xffffu)), bf2f((unsigned short)(vv.x >> 16)), bf2f((unsigned short)(vv.y & 0xffffu)), bf2f((unsigned short)(vv.y >> 16)),
                            bf2f((unsigned short)(vv.z & 0xffffu)), bf2f((unsigned short)(vv.z >> 16)), bf2f((unsigned short)(vv.w & 0xffffu)), bf2f((unsigned short)(vv.w >> 16))};
        float sx = 0.f;
#pragma unroll
        for (int j = 0; j < 8; ++j) sx += x[j];
        sx = sum8(sx); const float mean = sx * (1.f / 64.f); float qq = 0.f;
#pragma unroll
        for (int j = 0; j < 8; ++j) { x[j] -= mean; qq += x[j] * x[j]; }
        qq = sum8(qq); const float rstd = rsqrtf_(qq * (1.f / 64.f) + opq_f(GN_EPS)); float o[8];
#pragma unroll
        for (int j = 0; j < 8; ++j) o[j] = (x[j] * rstd * gg[j] + gb[j] + bs * v[j]) * g[j];
        *(half8*)(MIX + (size_t)row * DM + 1536 + c0) = f_to_h8(o); } }
    }
}

constexpr int PH_PER_LAYER = 11, N_PHASES = 2 + DEPTH * PH_PER_LAYER;
__global__ void __launch_bounds__(NWAVES * 64, 2) hse_fwd(Args args) {
    extern __shared__ __attribute__((aligned(16))) unsigned char lds_raw[];
    Frame F;
    F.lds = (LAS unsigned char*)lds_raw;
    const int G = gridDim.x, wave = __builtin_amdgcn_readfirstlane(threadIdx.x >> 6);
    F.ws = args.ws; F.out = args.out; F.wave = wave;
    volatile LAS unsigned* MISC = (volatile LAS unsigned*)(F.lds + MISC_OFF);
    if (threadIdx.x < 16) MISC[threadIdx.x] = 0u;
    __syncthreads();
#if MK_LAUNCH_MODE == 0
    XcdBarrier bar = xcd_barrier_post((unsigned*)(F.ws + WS_CTL) + CW_BAR, MISC + 8, wave);
#define GRID_BAR() xcd_barrier(bar)
#else
#define GRID_BAR() do {} while (0)
#endif
    const int lo = args.ph_lo, hi = args.ph_hi;
#define IN(k) (lo <= (k) && (k) < hi)
#define SEAM(k) do { if (IN((k) + 1)) GRID_BAR(); } while (0)
#define MOD wsp<float>(F, WS_MOD)
#define X wsp<float>(F, WS_X)
#define H16 wsp<h16>(F, WS_H16)
#define PROJ wsp<h16>(F, WS_PROJ)
    LAS unsigned char* ring = F.lds;

    if (PHE(11) && IN(0)) { p0_mod(F); s5_pow_tables(F, 0); convert_weights(F, 0, 2, wave, 8, wave * 16384); SEAM(0); }
    if (PHE(12) && IN(1)) { modulate_rows(F, inp(F, I_X), MOD, 0, H16); convert_weights(F, 0, 5, wave, 8, wave * 16384); SEAM(1); }

    for (int l = 0; l < DEPTH; ++l) {
        const int pb = 2 + l * PH_PER_LAYER;
#define modl (MOD + (size_t)l * BATCH * MODW)
        if (PHE(0) && IN(pb + 0)) { REPB(0, pg8::Gemm g{H16, wsp<h16>(F, WS_WIN), DM, DM, DM, 0, 0}; pg8::StaticOrder S; S.init(M, NIN, G, opq_bid());
            pg8::EpiProj E{PROJ, wsp<h16>(F, WS_UG)}; pg8::gemm_phase<pg8::EpiProj, pg8::StaticOrder, true>(ring, g, S, E, wave););
            SEAM(pb + 0); }
        if (PHE(1) && IN(pb + 1)) { REPB(1, { pg8::Gemm g{wsp<h16>(F, WS_UG), wsp<h16>(F, WS_S5T1), S5K3, 512, 512, (long)S5NC * S5K3, 256L * 512}; pg8::GroupOrder S; S.init(4, 1, 32, G, opq_bid());
                pg8::EpiS5h E{wsp<float>(F, WS_HLOC)}; if (PHE(15)) pg8::gemm_phase<pg8::EpiS5h, pg8::GroupOrder, true>(ring, g, S, E, wave); }
            __syncthreads();
            if (PHE(14)) { prep_rows(F, l); hgrn_prep(F, l); });
            SEAM(pb + 1); }
        if (PHE(2) && IN(pb + 2)) { REPB(2, { pg8::Gemm g{wsp<h16>(F, WS_RWA), wsp<h16>(F, WS_LRT), 256, 256, 256, 0, 0}; pg8::StaticOrder S; S.init(M, 1536, G, opq_bid());
                pg8::EpiLR E{wsp<h16>(F, WS_LR16)};
                if (PHE(17)) pg8::gemm_phase<pg8::EpiLR, pg8::StaticOrder, true>(ring, g, S, E, wave); }
            if (PHE(16)) { s5_chunk_scan(F, l); hgrn_loc_units(F); });
            SEAM(pb + 2); }
        if (PHE(3) && IN(pb + 3)) { REPB(3, { pg8::Gemm g{wsp<h16>(F, WS_UG), wsp<h16>(F, WS_S5T3), S5K3, S5K3, S5K3, (long)S5NC * S5K3, 512L * S5K3}; pg8::GroupOrder S; S.init(4, 2, 32, G, opq_bid());
                pg8::EpiS5y E{PROJ, inp(F, I_S5D) + l * DG, wsp<h16>(F, WS_Y16)}; pg8::gemm_phase<pg8::EpiS5y, pg8::GroupOrder, true>(ring, g, S, E, wave); }
            rwkv_chunk_prep(F, l); hgrn_state_scan(F); if (l + 1 < DEPTH) s5_pow_tables(F, l + 1); rwkv_sync_zero(F););
            SEAM(pb + 3); }
        if (PHE(4) && IN(pb + 4)) { REPB(4, if (wave == 0) rwkv_scan_consumer(F);
            else if (wave == 4 || wave == 5) rwkv_scan_loader(F, wave - 4);
            else { const int ws5 = wave < 4 ? wave - 1 : wave - 3; const float* ng = inp(F, I_HGNG) + l * DG;
                for (int un = opq_bid() * 5 + ws5; un < BATCH * 4 * 64 * 2; un += G * 5) hgrn_out_unit(F, un, ng);
                if (PHE(13)) attention_units(F, ws5, 5); if (l + 1 < DEPTH) convert_weights(F, l + 1, 4, ws5, 5, 0); });
            SEAM(pb + 4); }
        if (PHE(5) && IN(pb + 5)) { REPB(5, { pg8::Gemm g{wsp<h16>(F, WS_Y16), wsp<h16>(F, WS_GLU), DG, DG, DG, 0, 0}; pg8::StaticOrder S; S.init(M, DG, G, opq_bid());
                pg8::EpiGLU E{wsp<h16>(F, WS_Y16), inp(F, I_GLUB) + l * DG, H16}; pg8::gemm_phase<pg8::EpiGLU, pg8::StaticOrder, true>(ring, g, S, E, wave); }
            finalize_rows(F, l););
            SEAM(pb + 5); }
        if (PHE(6) && IN(pb + 6)) { REPB(6, pg8::Gemm g{H16, wsp<h16>(F, WS_WOUT), DM, DM, DM, 0, 0}; pg8::StaticOrder S; S.init(M, DM, G, opq_bid());
            pg8::EpiRes E{l == 0 ? inp(F, I_X) : X, X, modl + 2 * DM, l == 0 ? (const float*)nullptr : wsp<float>(F, WS_LNST), inp(F, I_LN2G) + (l > 0 ? l - 1 : 0) * DM, inp(F, I_LN2B) + (l > 0 ? l - 1 : 0) * DM};
            pg8::gemm_phase<pg8::EpiRes, pg8::StaticOrder, true>(ring, g, S, E, wave););
            SEAM(pb + 6); }
        if (PHE(7) && IN(pb + 7)) { REPB(7, ln_rows(F, X, (float*)nullptr, inp(F, I_LN1G) + l * DM, inp(F, I_LN1B) + l * DM, modl, 3, H16, wsp<float>(F, WS_LNST)););
            SEAM(pb + 7); }
        if (PHE(8) && IN(pb + 8)) { REPB(8, pg8::Gemm g{H16, wsp<h16>(F, WS_W13), DM, DM, DM, 0, 0}; pg8::StaticOrder S; S.init(M, 2 * DFF, G, opq_bid());
            pg8::EpiSwiGLU E{PROJ}; pg8::gemm_phase<pg8::EpiSwiGLU, pg8::StaticOrder, true>(ring, g, S, E, wave););
            SEAM(pb + 8); }
        if (PHE(9) && IN(pb + 9)) { REPB(9, pg8::Gemm g{PROJ, wsp<h16>(F, WS_W2), DFF, DFF, DFF, 0, 0}; pg8::StaticOrder S; S.init(M, DM, G, opq_bid());
            pg8::EpiRes E{X, X, modl + 5 * DM, wsp<float>(F, WS_LNST), inp(F, I_LN1G) + l * DM, inp(F, I_LN1B) + l * DM}; pg8::gemm_phase<pg8::EpiRes, pg8::StaticOrder, true>(ring, g, S, E, wave););
            SEAM(pb + 9); }
        if (PHE(10) && IN(pb + 10)) { REPB(10, const bool lastl = (l == DEPTH - 1);
            ln_rows(F, X, lastl ? F.out : (float*)nullptr, inp(F, I_LN2G) + l * DM, inp(F, I_LN2B) + l * DM, modl + (size_t)BATCH * MODW, 0, lastl ? (h16*)nullptr : H16, lastl ? (float*)nullptr : wsp<float>(F, WS_LNST));
            if (!lastl) { __syncthreads(); convert_weights(F, l + 1, 3, wave, 8, wave * 16384); });
            SEAM(pb + 10); }
    }
#undef IN
#undef SEAM
#undef MOD
#undef X
#undef H16
#undef PROJ
#undef modl
}

extern "C" void kernel_launch(void* const* d_in, const int* in_sizes, int n_in, void* d_out, int out_size, void* d_ws, size_t ws_size, hipStream_t stream) {
    static int grid = 0;
    if (grid == 0) {
        if (n_in != 36 || in_sizes[0] != M * DM || out_size != M * DM || ws_size < WS_END) { fprintf(stderr, "kernel_launch: unexpected shapes (n_in %d, in0 %d, out %d, ws %zu)\n", n_in, n_in > 0 ? in_sizes[0] : -1, out_size, ws_size); grid = -1; return; }
        int dev = 0, cus = 0, per_cu = 0;
        if (hipGetDevice(&dev) != hipSuccess || hipDeviceGetAttribute(&cus, hipDeviceAttributeMultiprocessorCount, dev) != hipSuccess) { grid = -1; return; }
        if (hipFuncSetAttribute((const void*)hse_fwd, hipFuncAttributeMaxDynamicSharedMemorySize, LDS_BYTES) != hipSuccess) { fprintf(stderr, "kernel_launch: hipFuncSetAttribute failed\n"); grid = -1; return; }
        if (hipOccupancyMaxActiveBlocksPerMultiprocessor(&per_cu, (const void*)hse_fwd, NWAVES * 64, LDS_BYTES) != hipSuccess || per_cu < 1) { fprintf(stderr, "kernel_launch: occupancy query reports %d\n", per_cu); }
        (void)hipGetLastError();
        grid = cus;
    }
    if (grid < 0) return;
    if (hipMemsetAsync((char*)d_ws + WS_CTL, 0, CTL_ZERO_BYTES, stream) != hipSuccess) return;
    Args a{};
    for (int i = 0; i < 36; ++i) a.in[i] = (const float*)d_in[i];
    a.out = (float*)d_out; a.ws = (unsigned char*)d_ws;
#if MK_LAUNCH_MODE == 0
    a.ph_lo = 0; a.ph_hi = N_PHASES;
    hipLaunchKernelGGL(hse_fwd, dim3(grid), dim3(NWAVES * 64), LDS_BYTES, stream, a);
#else
    for (int p = 0; p < N_PHASES; ++p) { a.ph_lo = p; a.ph_hi = p + 1; hipLaunchKernelGGL(hse_fwd, dim3(grid), dim3(NWAVES * 64), LDS_BYTES, stream, a); }
#endif
}
```

```cpp
#include <hip/hip_runtime.h>
#include <cstdio>
#include <cstdint>

#ifndef MK_LAUNCH_MODE
#define MK_LAUNCH_MODE 0
#endif

#ifndef PH_ENABLE
#define PH_ENABLE 0xFFFFF
#endif
#define PHE(k) (((PH_ENABLE) >> (k)) & 1)
#ifndef REPEAT_MASK
#define REPEAT_MASK 0
#endif
#define REPB(k, ...) do { __VA_ARGS__ if ((REPEAT_MASK >> (k)) & 1) { __syncthreads(); __VA_ARGS__ } } while (0)
#define LAS __attribute__((address_space(3)))
typedef _Float16 h16;
typedef _Float16 half8 __attribute__((ext_vector_type(8)));
typedef _Float16 half4 __attribute__((ext_vector_type(4)));
typedef _Float16 half2v __attribute__((ext_vector_type(2)));
typedef float f32x4 __attribute__((ext_vector_type(4)));
typedef float f32x2 __attribute__((ext_vector_type(2)));
typedef unsigned u32x4 __attribute__((ext_vector_type(4)));
typedef unsigned u32x2 __attribute__((ext_vector_type(2)));

constexpr int BATCH = 8, SEQ = 4096, DM = 2048, DEPTH = 4, M = BATCH * SEQ;
constexpr int DG = 512, NIN = 5888, RWOFF = 4096, DFF = 5632;
constexpr int MODW = 6 * DM;
constexpr float DN_ALPHA = 1.681792830507429f;
constexpr float LN_EPS = 1e-5f, RMS_EPS = 1e-6f, GN_EPS = 64e-5f;
constexpr int S5L = 32, S5NC = M / S5L;
constexpr int S5K3 = 640;

constexpr size_t MiB = 1u << 20;
constexpr size_t WS_CTL = 0, CTL_ZERO_BYTES = 64 * 1024;
constexpr size_t WS_MOD = 1 * MiB;
constexpr size_t WS_LB = 3 * MiB;
constexpr size_t WS_W16 = 16 * MiB;
constexpr size_t WS_WIN = WS_W16;
constexpr size_t WS_WOUT = WS_WIN + 23 * MiB;
constexpr size_t WS_W13 = WS_WOUT + 8 * MiB;
constexpr size_t WS_W2 = WS_W13 + 44 * MiB;
constexpr size_t WS_GLU = WS_W2 + 22 * MiB;
constexpr size_t WS_LRT = WS_GLU + 1 * MiB;
constexpr size_t WS_S5T3 = WS_LRT + 1 * MiB;
constexpr size_t WS_S5T1 = WS_S5T3 + 20 * MiB;
constexpr size_t WS_X = 152 * MiB;
constexpr size_t WS_H16 = 408 * MiB;
constexpr size_t WS_PROJ = 536 * MiB;
constexpr size_t WS_RWA = 904 * MiB;
constexpr size_t WS_HLOC = 920 * MiB;
constexpr size_t WS_Y16 = 904 * MiB;
constexpr size_t WS_LR16 = 936 * MiB;
constexpr size_t WS_RWREC = 1032 * MiB;
constexpr size_t WS_RWBON = 1240 * MiB;
constexpr size_t WS_HGK = 1256 * MiB;
constexpr size_t WS_HGQ = 1288 * MiB;
constexpr size_t WS_HGST = 1320 * MiB;
constexpr size_t WS_UG = 1384 * MiB;
constexpr size_t WS_RWRAW = 1384 * MiB;
constexpr size_t WS_LNST = 8 * MiB;
constexpr size_t WS_LPW = 6 * MiB;
constexpr size_t WS_BBR = 7 * MiB;
constexpr size_t WS_HGB = 4 * MiB;
constexpr size_t WS_END = 1424 * MiB;
static_assert(WS_S5T1 + 8 * MiB <= WS_X, "W16 map");
constexpr int CW_BAR = 1024;

constexpr int RING_BYTES = 131072, MISC_OFF = RING_BYTES + 64, LDS_BYTES = 147456;
constexpr int NWAVES = 8;

#define DI __device__ __forceinline__
DI int opq_lane() { int l; asm volatile("v_mbcnt_lo_u32_b32 %0, -1, 0\n\tv_mbcnt_hi_u32_b32 %0, -1, %0" : "=v"(l)); return l; }
DI unsigned pkh(float a, float b) { half2v h; h.x = (h16)a; h.y = (h16)b; return __builtin_bit_cast(unsigned, h); }
DI float sigmoidf_(float x) { return __builtin_amdgcn_rcpf(1.f + __expf(-x)); }
DI float siluf_(float x) { return x * sigmoidf_(x); }
DI float tanhf_(float x) { const float t = __expf(-2.f * fabsf(x)); const float r = (1.f - t) * __builtin_amdgcn_rcpf(1.f + t); return x < 0.f ? -r : r; }
DI float softplusf_(float x) { return fmaxf(x, 0.f) + 0.6931471805599453f * __builtin_amdgcn_logf(1.f + __expf(-fabsf(x))); }
DI float rsqrtf_(float x) { return __builtin_amdgcn_rsqf(x); }
DI float gelu_tanhf_(float y) { const float u = 1.5957691216057308f * (y + 0.044715f * y * y * y); return y * sigmoidf_(u); }
template <int CTRL> DI float dppf(float v) { return __builtin_bit_cast(float, __builtin_amdgcn_update_dpp(0, __builtin_bit_cast(int, v), CTRL, 0xf, 0xf, false)); }
DI float sum4(float v) { v += dppf<0xB1>(v); v += dppf<0x4E>(v); return v; }
DI float sum8(float v) { v = sum4(v); v += dppf<0x141>(v); return v; }
DI float sum16(float v) { v = sum8(v); v += dppf<0x140>(v); return v; }
DI float wave_sum(float v) {
#pragma unroll
    for (int o = 1; o < 64; o <<= 1) v += __shfl_xor(v, o);
    return v;
}
typedef short bf16x8 __attribute__((ext_vector_type(8)));
typedef short bf16x4 __attribute__((ext_vector_type(4)));
DI unsigned short f2bf(float f) { unsigned u = __builtin_bit_cast(unsigned, f); return (unsigned short)((u + 0x7fffu + ((u >> 16) & 1u)) >> 16); }
DI float bf2f(unsigned short b) { return __builtin_bit_cast(float, (unsigned)b << 16); }
DI void h8_to_f(const half8 h, float (&f)[8]) {
#pragma unroll
    for (int i = 0; i < 8; ++i) f[i] = (float)h[i];
}
DI half8 f_to_h8(const float (&f)[8]) { half8 h;
#pragma unroll
    for (int i = 0; i < 8; ++i) h[i] = (h16)f[i];
    return h; }

#define XB_TMO      128
#define XB_XCNT(j)  (256  + 64 * (j))
#define XB_XSUB(j)  (1280 + 64 * (j))
#define XB_XGEN(j)  (2304 + 64 * (j))
#define XB_TOP      3328
#define XB_TOPGEN   3392
#define XCD_BAR_WORDS 3456
#define XB_SPIN_CAP (1u << 20)
__device__ __forceinline__ unsigned xb_ld(unsigned* p)              { return __hip_atomic_load(p, __ATOMIC_RELAXED, __HIP_MEMORY_SCOPE_AGENT); }
__device__ __forceinline__ unsigned xb_add(unsigned* p, unsigned v) { return __hip_atomic_fetch_add(p, v, __ATOMIC_RELAXED, __HIP_MEMORY_SCOPE_AGENT); }
__device__ __forceinline__ unsigned xb_xcc_id() { return (unsigned)__builtin_amdgcn_s_getreg((3 << 11) | 20) & 0xFu; }
#define XB_SPIN(cond, bar) do { unsigned _sp = 0; while (cond) { __builtin_amdgcn_s_sleep(1); \
    if ((++_sp & 255u) == 0u) { if (xb_ld(&(bar)[XB_TMO])) break; if (_sp > XB_SPIN_CAP) { atomicAdd(&(bar)[XB_TMO], 1u); break; } } } } while (0)
struct XcdBarrier { unsigned* bar; unsigned x; volatile LAS unsigned* st; int wave; };
__device__ __forceinline__ XcdBarrier xcd_barrier_post(unsigned* bar, volatile LAS unsigned* st, int wave) {
    XcdBarrier b; b.bar = bar; b.x = xb_xcc_id(); b.st = st; b.wave = wave;
    if (wave == 0 && opq_lane() == 0) (void)xb_add(&bar[XB_XCNT(b.x)], 1u);
    return b;
}
__device__ __forceinline__ void xcd_barrier_complete(unsigned* bar, unsigned x, unsigned& nloc, unsigned& nx) {
    const unsigned G = gridDim.x * gridDim.y * gridDim.z;
    asm volatile("" : "+s"(x));
    unsigned sum, cnt, mine, sp = 0u;
    for (;;) {
        sum = 0u; cnt = 0u; mine = 0u;
#pragma unroll
        for (unsigned j = 0; j < 16; ++j) { const unsigned c = xb_ld(&bar[XB_XCNT(j)]); sum += c; cnt += (c > 0u) ? 1u : 0u; mine = (j == x) ? c : mine; }
        if (sum == G) break;
        __builtin_amdgcn_s_sleep(1);
        if ((++sp & 255u) == 0u) { if (xb_ld(&bar[XB_TMO])) break; if (sp > XB_SPIN_CAP) { atomicAdd(&bar[XB_TMO], 1u); break; } }
    }
    nloc = mine > 0u ? mine : 1u; nx = cnt > 0u ? cnt : 1u;
}
__device__ __forceinline__ void xcd_barrier(const XcdBarrier& b) {
    asm volatile("s_waitcnt vmcnt(0)" ::: "memory");
    __syncthreads();
    if (b.wave == 0 && opq_lane() == 0) {
        unsigned* bar = b.bar; asm volatile("" : "+s"(bar));
        __builtin_amdgcn_s_waitcnt(0);
        unsigned nloc = b.st[0], nx = b.st[1];
        if (nloc == 0u) { xcd_barrier_complete(bar, b.x, nloc, nx); b.st[0] = nloc; b.st[1] = nx; }
        const unsigned old = xb_add(&bar[XB_XSUB(b.x)], 1u);
        const unsigned gen = old / nloc;
        if (old + 1u == (gen + 1u) * nloc) {
            __builtin_amdgcn_fence(__ATOMIC_RELEASE, "agent");
            asm volatile("s_waitcnt vmcnt(0)" ::: "memory");
            const unsigned og = xb_add(&bar[XB_TOP], 1u);
            const unsigned tg = og / nx;
            if (og + 1u == (tg + 1u) * nx) xb_add(&bar[XB_TOPGEN], 1u);
            else XB_SPIN(xb_ld(&bar[XB_TOPGEN]) == tg, bar);
            __builtin_amdgcn_fence(__ATOMIC_ACQUIRE, "agent");
            xb_add(&bar[XB_XGEN(b.x)], 1u);
            asm volatile("s_waitcnt vmcnt(0)" ::: "memory");
        } else {
            XB_SPIN(xb_ld(&bar[XB_XGEN(b.x)]) == gen, bar);
            __builtin_amdgcn_fence(__ATOMIC_ACQUIRE, "agent");
            asm volatile("s_waitcnt vmcnt(0)" ::: "memory");
        }
    }
    __syncthreads();
}

namespace pg8 {
constexpr int BM = 256, BK = 64, HALF = 128, HTB = HALF * BK * 2, STAGE_BYTES = 8 * HTB, NXCD = 8, WGM = 8;
__host__ __device__ __forceinline__ int lds_byte(int r, int c) { const int st = (r >> 4) * 2 + (c >> 5), rr = r & 15, cc = c & 31, ob = rr * 64 + cc * 2; return st * 1024 + (ob ^ (((ob >> 9) & 1) << 5)); }
__host__ __device__ __forceinline__ void stage_rc(int b, int& R, int& C) { const int st = b / 1024, sb = b % 1024, swz = sb ^ (((sb >> 9) & 1) << 5); R = (st >> 1) * 16 + swz / 64; C = (st & 1) * 32 + (swz % 64) / 2; }
__host__ __device__ __forceinline__ int perm32(int rho) { const int n = rho >> 4, i = rho & 15; return 8 * (i >> 2) + 4 * n + (i & 3); }

struct Unit { int pm, pn, g; };
struct Gemm { const h16* A; const h16* Bt; int lda, ldb, K; long gsA, gsB; };

struct StaticOrder {
    int nM, nN, nwg, G, c;
    __device__ void init(int M_, int N_, int G_, int c_) { nM = M_ / BM; nN = N_ / BM; nwg = nM * nN; G = G_; c = c_; }
    __device__ bool next(int i, Unit& u) const {
        const long L = (long)i * G + c; if (L >= nwg) return false;
        int wgid = (int)L; { const int q = nwg / NXCD, r = nwg % NXCD, xcd = wgid % NXCD, off = wgid / NXCD; wgid = (xcd < r ? xcd * (q + 1) : r * (q + 1) + (xcd - r) * q) + off; }
        const int nig = WGM * nN, gid = wgid / nig, fm = gid * WGM, gsz = (nM - fm) < WGM ? (nM - fm) : WGM;
        u.pm = fm + ((wgid % nig) % gsz); u.pn = (wgid % nig) / gsz; u.g = 0; return true;
    }
};
struct GroupOrder {
    int nM, nN, per, total, G, c;
    __device__ void init(int nM_, int nN_, int ng, int G_, int c_) { nM = nM_; nN = nN_; per = nM_ * nN_; total = per * ng; G = G_; c = c_; }
    __device__ bool next(int i, Unit& u) const {
        const long L = (long)i * G + c; if (L >= total) return false;
        const int l = (int)L; u.g = l / per; const int r = l % per; u.pm = r % nM; u.pn = r / nM; return true;
    }
};

__device__ __forceinline__ void glds16_s(const char* gbase, unsigned voff, unsigned lds_dst) {
    unsigned keep;
    asm volatile("s_mov_b32 %0, m0\n\ts_mov_b32 m0, %2\n\ts_nop 0\n\tglobal_load_lds_dwordx4 %1, %3\n\ts_mov_b32 m0, %0" : "=&s"(keep) : "v"(voff), "s"(lds_dst), "s"(gbase) : "memory");
}
template <class Epi, class Sched, bool ALIGN_EPI>
__device__ __forceinline__ void gemm_phase(LAS unsigned char* lds, const Gemm g, const Sched& S, const Epi& E, const int wid_in) {
    int lane; asm volatile("v_mbcnt_lo_u32_b32 %0, -1, 0\n\tv_mbcnt_hi_u32_b32 %0, -1, %0" : "=v"(lane));
    int wid = wid_in; asm volatile("" : "+s"(wid));
    const int tid = wid * 64 + lane, wr = wid >> 2, wc = wid & 3, fr = lane & 15, fq = lane >> 4;
    const int K = g.K, nt = K / BK;
    unsigned voffA[2], voffB[2];
#pragma unroll
    for (int i = 0; i < 2; ++i) { int R, C; stage_rc(tid * 16 + i * 8192, R, C); const int Rb = Epi::PERM ? ((R & ~31) + perm32(R & 31)) : R;
        voffA[i] = (unsigned)(R * g.lda + C) * 2u; voffB[i] = (unsigned)(Rb * g.ldb + C) * 2u; }
    const size_t kstep = (size_t)(BK * 2);
    const size_t hstepA = (size_t)HALF * g.lda * 2, hstepB = (size_t)HALF * g.ldb * 2;
    const size_t tstepA = 2 * hstepA, tstepB = 2 * hstepB;
    const unsigned ldsw = (unsigned)wid * 1024u, lds_u = (unsigned)(size_t)lds;
    const int aoff = lds_byte(wr * 64 + fr, fq * 8), boff = lds_byte(wc * 32 + fr, fq * 8);
#define PG8_SA(b, h) (((b) * 2 + (h)) * HTB)
#define PG8_SB(b, h) ((4 + (b) * 2 + (h)) * HTB)
#define PG8_STAGE(bufoff, gbase, voff) do { _Pragma("unroll") for (int _i = 0; _i < 2; ++_i) glds16_s((const char*)(gbase), (voff)[_i], lds_u + (unsigned)((bufoff) + _i * 8192) + ldsw); } while (0)
#define PG8_LDA(dst, b, h) do { _Pragma("unroll") for (int m = 0; m < 4; ++m) _Pragma("unroll") for (int k = 0; k < 2; ++k) dst[m][k] = *(const LAS half8*)(lds + PG8_SA(b, h) + aoff + m * 2048 + k * 1024); } while (0)
#define PG8_LDB(dst, b, h) do { _Pragma("unroll") for (int n = 0; n < 2; ++n) _Pragma("unroll") for (int k = 0; k < 2; ++k) dst[n][k] = *(const LAS half8*)(lds + PG8_SB(b, h) + boff + n * 2048 + k * 1024); } while (0)
#define PG8_MMA(ai, bj, At, Bt) do { __builtin_amdgcn_s_setprio(1); _Pragma("unroll") for (int m = 0; m < 4; ++m) _Pragma("unroll") for (int n = 0; n < 2; ++n) _Pragma("unroll") for (int k = 0; k < 2; ++k) \
        acc[ai][bj][m][n] = __builtin_amdgcn_mfma_f32_16x16x32_f16(Bt[n][k], At[m][k], acc[ai][bj][m][n], 0, 0, 0); __builtin_amdgcn_s_setprio(0); } while (0)
#define PG8_WAIT_V(n) asm volatile("s_waitcnt vmcnt(" #n ")" ::: "memory")
#define PG8_WAIT_L(n) asm volatile("s_waitcnt lgkmcnt(" #n ")" ::: "memory")
#define PG8_BAR __builtin_amdgcn_s_barrier()
#define PG8_SCHED __builtin_amdgcn_sched_barrier(0)
    Unit cur, nxt; int ui = 0;
    if (!S.next(0, cur)) return;
    f32x4 acc[2][2][4][2];
#pragma unroll
    for (int a = 0; a < 2; ++a)
#pragma unroll
        for (int b = 0; b < 2; ++b)
#pragma unroll
            for (int m = 0; m < 4; ++m)
#pragma unroll
                for (int n = 0; n < 2; ++n) acc[a][b][m][n] = (f32x4){0.f, 0.f, 0.f, 0.f};
    half8 At[4][2], B0[2][2], B1[2][2];
    const char* cA = (const char*)g.A + (size_t)cur.g * g.gsA * 2 + (size_t)cur.pm * tstepA;
    const char* cB = (const char*)g.Bt + (size_t)cur.g * g.gsB * 2 + (size_t)cur.pn * tstepB;
    PG8_STAGE(PG8_SB(0, 0), cB, voffB); PG8_STAGE(PG8_SB(0, 1), cB + hstepB, voffB); PG8_STAGE(PG8_SA(0, 0), cA, voffA); PG8_STAGE(PG8_SA(0, 1), cA + hstepA, voffA);
    if (wr == 1) PG8_BAR;
    PG8_WAIT_V(2); PG8_BAR;
    PG8_STAGE(PG8_SB(1, 0), cB + kstep, voffB); PG8_STAGE(PG8_SA(1, 0), cA + kstep, voffA); PG8_STAGE(PG8_SB(1, 1), cB + hstepB + kstep, voffB);
    PG8_WAIT_V(6); PG8_BAR;
    for (;;) {
        const bool has_next = S.next(ui + 1, nxt);
        const char* nA = has_next ? (const char*)g.A + (size_t)nxt.g * g.gsA * 2 + (size_t)nxt.pm * tstepA : cA;
        const char* nB = has_next ? (const char*)g.Bt + (size_t)nxt.g * g.gsB * 2 + (size_t)nxt.pn * tstepB : cB;
        for (int t = 0; t < nt; t += 2) {
            const bool last = (t == nt - 2);
            const char* a1 = cA + (size_t)(t + 1) * kstep;
            const char* a2 = last ? nA : cA + (size_t)(t + 2) * kstep; const char* b2 = last ? nB : cB + (size_t)(t + 2) * kstep;
            const char* a3 = a2 + kstep; const char* b3 = b2 + kstep;
            PG8_LDB(B0, 0, 0); PG8_LDB(B1, 0, 1); PG8_SCHED; PG8_LDA(At, 0, 0); PG8_STAGE(PG8_SA(1, 1), a1 + hstepA, voffA);
            PG8_WAIT_V(8); PG8_WAIT_L(0); PG8_BAR; PG8_MMA(0, 0, At, B0); PG8_MMA(0, 1, At, B1); PG8_BAR; PG8_SCHED;
            PG8_LDA(At, 0, 1); PG8_STAGE(PG8_SB(0, 0), b2, voffB); PG8_STAGE(PG8_SB(0, 1), b2 + hstepB, voffB); PG8_STAGE(PG8_SA(0, 0), a2, voffA);
            PG8_WAIT_V(8); PG8_WAIT_L(0); PG8_BAR; PG8_MMA(1, 0, At, B0); PG8_MMA(1, 1, At, B1); PG8_BAR; PG8_SCHED;
            PG8_LDB(B0, 1, 0); PG8_LDB(B1, 1, 1); PG8_SCHED; PG8_LDA(At, 1, 0); PG8_STAGE(PG8_SA(0, 1), a2 + hstepA, voffA);
            PG8_WAIT_V(8); PG8_WAIT_L(0); PG8_BAR; PG8_MMA(0, 0, At, B0); PG8_MMA(0, 1, At, B1); PG8_BAR; PG8_SCHED;
            PG8_LDA(At, 1, 1); PG8_STAGE(PG8_SB(1, 0), b3, voffB); PG8_STAGE(PG8_SB(1, 1), b3 + hstepB, voffB); PG8_STAGE(PG8_SA(1, 0), a3, voffA);
            PG8_WAIT_V(8); PG8_WAIT_L(0); PG8_BAR; PG8_MMA(1, 0, At, B0); PG8_MMA(1, 1, At, B1); PG8_BAR; PG8_SCHED;
        }
        if constexpr (ALIGN_EPI) { if (wr == 0) PG8_BAR; }
        { int ln2; asm volatile("v_mbcnt_lo_u32_b32 %0, -1, 0\n\tv_mbcnt_hi_u32_b32 %0, -1, %0" : "=v"(ln2)); E(acc, cur, wr, wc, ln2 & 15, ln2 >> 4); }
        if (!has_next) break;
#pragma unroll
        for (int a = 0; a < 2; ++a)
#pragma unroll
            for (int b = 0; b < 2; ++b)
#pragma unroll
                for (int m = 0; m < 4; ++m)
#pragma unroll
                    for (int n = 0; n < 2; ++n) acc[a][b][m][n] = (f32x4){0.f, 0.f, 0.f, 0.f};
        cur = nxt; cA = nA; cB = nB; ++ui;
        if constexpr (ALIGN_EPI) { if (wr == 1) PG8_BAR; }
    }
    PG8_WAIT_V(0);
    if constexpr (!ALIGN_EPI) { if (wr == 0) PG8_BAR; }
    PG8_BAR;
#undef PG8_SA
#undef PG8_SB
#undef PG8_STAGE
#undef PG8_LDA
#undef PG8_LDB
#undef PG8_MMA
#undef PG8_WAIT_V
#undef PG8_WAIT_L
#undef PG8_BAR
#undef PG8_SCHED
}

typedef f32x4 Acc[2][2][4][2];

struct EpiProj {
    static constexpr bool PERM = true;
    h16* P; h16* UG;
    DI void operator()(const Acc& acc, const Unit& u, int wr, int wc, int fr, int fq) const {
        const int row0 = u.pm * BM + wr * 64 + fr, col0 = u.pn * BM + wc * 32 + 8 * fq;
        const bool s5 = (u.pn == 8 || u.pn == 9);
#pragma unroll
        for (int ai = 0; ai < 2; ++ai)
#pragma unroll
            for (int m = 0; m < 4; ++m) { const int row = row0 + ai * HALF + m * 16;
#pragma unroll
                for (int bj = 0; bj < 2; ++bj) { const f32x4 v0 = acc[ai][bj][m][0], v1 = acc[ai][bj][m][1]; const int c = col0 + bj * HALF;
                    u32x4 w; w.x = pkh(v0[0], v0[1]); w.y = pkh(v0[2], v0[3]); w.z = pkh(v1[0], v1[1]); w.w = pkh(v1[2], v1[3]);
                    *(u32x4*)(P + (size_t)row * NIN + c) = w;
                    if (s5) { const int cc = c - 2048, gg = cc >> 4, ch = cc & 15, bc = row >> 5, t = row & 31;
                        *(u32x4*)(UG + ((size_t)gg * S5NC + bc) * S5K3 + t * 16 + ch) = w; } }
                asm volatile("" ::: "memory"); }
    }
};
struct EpiRes {
    static constexpr bool PERM = false;
    const float* xin32; const h16* xin16; h16* xout; const float* gate;
    const float* lnst; const float* lng; const float* lnb;
    DI void operator()(const Acc& acc, const Unit& u, int wr, int wc, int fr, int fq) const {
        const int row0 = u.pm * BM + wr * 64 + fr, col0 = u.pn * BM + wc * 32 + 4 * fq, b = u.pm >> 4;
        f32x4 gv[2][2], lg[2][2], lb[2][2];
#pragma unroll
        for (int bj = 0; bj < 2; ++bj)
#pragma unroll
            for (int n = 0; n < 2; ++n) { gv[bj][n] = *(const f32x4*)(gate + (size_t)b * MODW + col0 + bj * HALF + n * 16);
                if (lnst) { lg[bj][n] = *(const f32x4*)(lng + col0 + bj * HALF + n * 16) * DN_ALPHA; lb[bj][n] = *(const f32x4*)(lnb + col0 + bj * HALF + n * 16) * DN_ALPHA; }
                else { lg[bj][n] = (f32x4){DN_ALPHA, DN_ALPHA, DN_ALPHA, DN_ALPHA}; lb[bj][n] = (f32x4){0.f, 0.f, 0.f, 0.f}; } }
#pragma unroll
        for (int ai = 0; ai < 2; ++ai)
#pragma unroll
            for (int m = 0; m < 4; ++m) { const size_t row = (size_t)(row0 + ai * HALF + m * 16); const size_t off = row * DM + col0; f32x4 xv[2][2];
                f32x2 st = {0.f, 1.f};
                if (lnst) { st = *(const f32x2*)(lnst + 2 * row); half4 xh[2][2];
#pragma unroll
                    for (int bj = 0; bj < 2; ++bj)
#pragma unroll
                        for (int n = 0; n < 2; ++n) xh[bj][n] = *(const half4*)(xin16 + off + bj * HALF + n * 16);
#pragma unroll
                    for (int bj = 0; bj < 2; ++bj)
#pragma unroll
                        for (int n = 0; n < 2; ++n) xv[bj][n] = (f32x4){(float)xh[bj][n][0], (float)xh[bj][n][1], (float)xh[bj][n][2], (float)xh[bj][n][3]}; }
                else {
#pragma unroll
                    for (int bj = 0; bj < 2; ++bj)
#pragma unroll
                        for (int n = 0; n < 2; ++n) xv[bj][n] = *(const f32x4*)(xin32 + off + bj * HALF + n * 16); }
#pragma unroll
                for (int bj = 0; bj < 2; ++bj)
#pragma unroll
                    for (int n = 0; n < 2; ++n) { const f32x4 y = ((xv[bj][n] - st.x) * st.y) * lg[bj][n] + lb[bj][n] + gv[bj][n] * acc[ai][bj][m][n];
                        u32x2 w; w.x = pkh(y[0], y[1]); w.y = pkh(y[2], y[3]); *(u32x2*)(xout + off + bj * HALF + n * 16) = w; }
                asm volatile("" ::: "memory"); }
    }
};
struct EpiSwiGLU {
    static constexpr bool PERM = true;
    h16* O;
    DI void operator()(const Acc& acc, const Unit& u, int wr, int wc, int fr, int fq) const {
        const int row0 = u.pm * BM + wr * 64 + fr, col0 = u.pn * HALF + wc * 32 + 8 * fq;
#pragma unroll
        for (int ai = 0; ai < 2; ++ai)
#pragma unroll
            for (int m = 0; m < 4; ++m) { float o[8];
#pragma unroll
                for (int n = 0; n < 2; ++n)
#pragma unroll
                    for (int j = 0; j < 4; ++j) o[4 * n + j] = siluf_(acc[ai][0][m][n][j]) * acc[ai][1][m][n][j];
                u32x4 w; w.x = pkh(o[0], o[1]); w.y = pkh(o[2], o[3]); w.z = pkh(o[4], o[5]); w.w = pkh(o[6], o[7]);
                *(u32x4*)(O + (size_t)(row0 + ai * HALF + m * 16) * DFF + col0) = w; asm volatile("" ::: "memory"); }
    }
};
struct EpiLR {
    static constexpr bool PERM = true;
    h16* O;
    DI void operator()(const Acc& acc, const Unit& u, int wr, int wc, int fr, int fq) const {
        const int row0 = u.pm * BM + wr * 64 + fr, col0 = u.pn * BM + wc * 32 + 8 * fq;
#pragma unroll
        for (int ai = 0; ai < 2; ++ai)
#pragma unroll
            for (int m = 0; m < 4; ++m) { const int row = row0 + ai * HALF + m * 16;
#pragma unroll
                for (int bj = 0; bj < 2; ++bj) { const f32x4 v0 = acc[ai][bj][m][0], v1 = acc[ai][bj][m][1];
                    u32x4 w; w.x = pkh(v0[0], v0[1]); w.y = pkh(v0[2], v0[3]); w.z = pkh(v1[0], v1[1]); w.w = pkh(v1[2], v1[3]);
                    *(u32x4*)(O + (size_t)row * 1536 + col0 + bj * HALF) = w; }
                asm volatile("" ::: "memory"); }
    }
};
struct EpiS5h {
    static constexpr bool PERM = false;
    float* H;
    DI void operator()(const Acc& acc, const Unit& u, int wr, int wc, int fr, int fq) const {
        const int row0 = u.pm * BM + wr * 64 + fr, col0 = wc * 32 + 4 * fq;
#pragma unroll
        for (int ai = 0; ai < 2; ++ai)
#pragma unroll
            for (int m = 0; m < 4; ++m)
#pragma unroll
                for (int n = 0; n < 2; ++n) *(f32x4*)(H + ((size_t)u.g * S5NC + row0 + ai * HALF + m * 16) * 128 + col0 + n * 16) = acc[ai][0][m][n];
    }
};
struct EpiS5y {
    static constexpr bool PERM = true;
    const h16* P; const float* dskip; h16* Y;
    DI void operator()(const Acc& acc, const Unit& u, int wr, int wc, int fr, int fq) const {
        const int row0 = u.pm * BM + wr * 64 + fr, col0 = u.pn * BM + wc * 32 + 8 * fq;
#pragma unroll
        for (int bj = 0; bj < 2; ++bj) { const int c = col0 + bj * HALF, t = c >> 4, ch = c & 15, chan = u.g * 16 + ch;
            const f32x4 d0 = *(const f32x4*)(dskip + chan), d1 = *(const f32x4*)(dskip + chan + 4);
#pragma unroll
            for (int ai = 0; ai < 2; ++ai) { half8 uv[4];
#pragma unroll
                for (int m = 0; m < 4; ++m) { const size_t tok = (size_t)(row0 + ai * HALF + m * 16) * S5L + t; uv[m] = *(const half8*)(P + tok * NIN + 2048 + chan); }
#pragma unroll
                for (int m = 0; m < 4; ++m) { const size_t tok = (size_t)(row0 + ai * HALF + m * 16) * S5L + t; float o[8];
#pragma unroll
                    for (int j2 = 0; j2 < 4; ++j2) { o[j2] = gelu_tanhf_(acc[ai][bj][m][0][j2] + d0[j2] * (float)uv[m][j2]); o[4 + j2] = gelu_tanhf_(acc[ai][bj][m][1][j2] + d1[j2] * (float)uv[m][4 + j2]); }
                    u32x4 w; w.x = pkh(o[0], o[1]); w.y = pkh(o[2], o[3]); w.z = pkh(o[4], o[5]); w.w = pkh(o[6], o[7]);
                    *(u32x4*)(Y + tok * DG + chan) = w; }
                asm volatile("" ::: "memory"); } }
    }
};
struct EpiGLU {
    static constexpr bool PERM = true;
    const h16* Y; const float* gb; h16* MIX;
    DI void operator()(const Acc& acc, const Unit& u, int wr, int wc, int fr, int fq) const {
        const int row0 = u.pm * BM + wr * 64 + fr, col0 = u.pn * BM + wc * 32 + 8 * fq;
#pragma unroll
        for (int bj = 0; bj < 2; ++bj) { const int c = col0 + bj * HALF; const f32x4 b0 = *(const f32x4*)(gb + c), b1 = *(const f32x4*)(gb + c + 4);
#pragma unroll
            for (int ai = 0; ai < 2; ++ai) { half8 yv[4];
#pragma unroll
                for (int m = 0; m < 4; ++m) yv[m] = *(const half8*)(Y + (size_t)(row0 + ai * HALF + m * 16) * DG + c);
#pragma unroll
                for (int m = 0; m < 4; ++m) { const size_t row = (size_t)(row0 + ai * HALF + m * 16); float o[8];
#pragma unroll
                    for (int j2 = 0; j2 < 4; ++j2) { o[j2] = (float)yv[m][j2] * sigmoidf_(acc[ai][bj][m][0][j2] + b0[j2]); o[4 + j2] = (float)yv[m][4 + j2] * sigmoidf_(acc[ai][bj][m][1][j2] + b1[j2]); }
                    u32x4 w; w.x = pkh(o[0], o[1]); w.y = pkh(o[2], o[3]); w.z = pkh(o[4], o[5]); w.w = pkh(o[6], o[7]);
                    *(u32x4*)(MIX + row * DM + 512 + c) = w; }
                asm volatile("" ::: "memory"); } }
    }
};
}

struct Args { const float* in[36]; float* out; unsigned char* ws; int ph_lo, ph_hi; };
enum { I_X = 0, I_C, I_ADAW, I_ADAB, I_WIN, I_WOUT, I_HGLB, I_HGNG, I_S5ARE, I_S5AIM, I_S5LDT, I_S5BRE, I_S5BIM, I_S5CRE, I_S5CIM, I_S5D, I_GLUW, I_GLUB,
       I_RWMU, I_RWW0, I_RWW2, I_RWA0, I_RWA2, I_RWG2, I_RWKK, I_RWKA, I_RWRK, I_RWGNG, I_RWGNB, I_LN1G, I_LN1B, I_FW1, I_FW3, I_FW2, I_LN2G, I_LN2B };

struct Frame {
    LAS unsigned char* lds;
    unsigned char* ws; float* out; int wave;
};
DI int opq_bid() { int b = blockIdx.x; asm volatile("" : "+s"(b)); return b; }
DI float opq_f(float c) { asm volatile("" : "+s"(c)); return c; }
#define PHASE_IDS const int lane = opq_lane(), wave = F.wave, tid = wave * 64 + lane, G = gridDim.x, bid = opq_bid(), gw = bid * NWAVES + wave, NGW = G * NWAVES; (void)lane; (void)gw; (void)NGW; (void)G; (void)bid; (void)tid;
template <class T> DI T* wsp(const Frame& F, size_t off) { unsigned o = (unsigned)off; asm volatile("" : "+s"(o)); return (T*)(F.ws + o); }
DI const float* inp(const Frame& F, int i) { (void)F; int k = i; asm volatile("" : "+s"(k));
    const __attribute__((address_space(4))) unsigned long long* t = (const __attribute__((address_space(4))) unsigned long long*)__builtin_amdgcn_kernarg_segment_ptr(); return (const float*)t[k]; }
struct TrDesc { const float* W; h16* WT; int N, ldd, w13add, k0, n0; };
DI void tr_load(const TrDesc& d, int lane, f32x4 (&v)[8]) { const int rl = lane >> 3, c4 = lane & 7;
#pragma unroll
    for (int i = 0; i < 8; ++i) v[i] = *(const f32x4*)(d.W + (size_t)(d.k0 + rl + 8 * i) * d.N + d.n0 + 4 * c4); }
DI void tr_store(const TrDesc& d, int lane, const f32x4 (&v)[8], LAS float* scr) { const int rl = lane >> 3, c4 = lane & 7;
#pragma unroll
    for (int i = 0; i < 8; ++i)
#pragma unroll
        for (int e = 0; e < 4; ++e) scr[(4 * c4 + e) * 65 + rl + 8 * i] = v[i][e];
    asm volatile("s_waitcnt lgkmcnt(0)" ::: "memory");
    const int c = lane & 7;
#pragma unroll
    for (int j = 0; j < 4; ++j) { const int n = (lane >> 3) + 8 * j; const LAS float* sp = scr + n * 65 + 8 * c; const int nn = d.n0 + n;
        const int row = d.w13add < 0 ? nn : 256 * (nn >> 7) + (nn & 127) + d.w13add;
        u32x4 o; o.x = pkh(sp[0], sp[1]); o.y = pkh(sp[2], sp[3]); o.z = pkh(sp[4], sp[5]); o.w = pkh(sp[6], sp[7]);
        *(u32x4*)(d.WT + (size_t)row * d.ldd + d.k0 + 8 * c) = o; }
    asm volatile("s_waitcnt lgkmcnt(0)" ::: "memory");
}
DI void cis_turns(double turns, float& c, float& s) { const double fr = turns - __builtin_rint(turns); const float f = (float)fr; c = __builtin_amdgcn_cosf(f); s = __builtin_amdgcn_sinf(f); }
struct S5Par { float ar, ai, dt; };
DI void s5_lampow(const S5Par& p, int tau, float& lr, float& li) {
    const float mag = __expf(p.ar * p.dt * (float)tau);
    float c, s; cis_turns((double)p.ai * (double)p.dt * (double)tau * 0.15915494309189535, c, s);
    lr = mag * c; li = mag * s;
}
DI void s5_z(const S5Par& p, float& zr, float& zi) {
    float lr, li; s5_lampow(p, 1, lr, li);
    const float rden = __builtin_amdgcn_rcpf(p.ar * p.ar + p.ai * p.ai);
    zr = ((lr - 1.f) * p.ar + li * p.ai) * rden; zi = (li * p.ar - (lr - 1.f) * p.ai) * rden;
}

DI void s5_pow_tables(const Frame& F, int l) { PHASE_IDS
    const float* are = inp(F, I_S5ARE) + l * 2048; const float* aim = inp(F, I_S5AIM) + l * 2048; const float* ldt = inp(F, I_S5LDT) + l * 32;
    const float* bre = inp(F, I_S5BRE) + (size_t)l * 32768; const float* bim = inp(F, I_S5BIM) + (size_t)l * 32768;
    float* LPW = wsp<float>(F, WS_LPW); float* BBR = wsp<float>(F, WS_BBR);
    for (int i = bid * 512 + tid; i < 2048 * 33; i += G * 512) { const int gp = i / 33, d = i - gp * 33; S5Par sp{are[gp], aim[gp], __expf(ldt[gp >> 6])}; float lr, li; s5_lampow(sp, d, lr, li); LPW[2 * i] = lr; LPW[2 * i + 1] = li; }
    for (int i = bid * 512 + tid; i < 2048 * 16; i += G * 512) { const int gp = i >> 4; S5Par sp{are[gp], aim[gp], __expf(ldt[gp >> 6])}; float zr, zi; s5_z(sp, zr, zi);
        const float br = bre[i], bi = bim[i]; BBR[2 * i] = zr * br - zi * bi; BBR[2 * i + 1] = zr * bi + zi * br; }
}
DI void convert_weights(const Frame& F, int l, int parts, int ws, int nwb, int scr_off) { PHASE_IDS
    const int gwp = bid * nwb + ws, NWP = G * nwb;
    LAS float* scr = (LAS float*)(F.lds + scr_off);
    constexpr int I_A = (DM / 64) * (NIN / 32), I_B = (DM / 64) * (DM / 32), I_C1 = (DM / 64) * (DFF / 32), I_D = (DFF / 64) * (DM / 32), I_E = (DG / 64) * (DG / 32);
    const int it_lo = (parts & 1) ? 0 : I_A, it_hi = (parts & 2) ? I_A + I_B + 2 * I_C1 + I_D + I_E : I_A;
#define TR_DESC(d, it) do { int r = (it); \
        if (r < I_A) { d.W = inp(F, I_WIN) + (size_t)l * DM * NIN; d.WT = wsp<h16>(F, WS_WIN); d.N = NIN; d.ldd = DM; d.w13add = -1; } \
        else if ((r -= I_A) < I_B) { d.W = inp(F, I_WOUT) + (size_t)l * DM * DM; d.WT = wsp<h16>(F, WS_WOUT); d.N = DM; d.ldd = DM; d.w13add = -1; } \
        else if ((r -= I_B) < I_C1) { d.W = inp(F, I_FW1) + (size_t)l * DM * DFF; d.WT = wsp<h16>(F, WS_W13); d.N = DFF; d.ldd = DM; d.w13add = 0; } \
        else if ((r -= I_C1) < I_C1) { d.W = inp(F, I_FW3) + (size_t)l * DM * DFF; d.WT = wsp<h16>(F, WS_W13); d.N = DFF; d.ldd = DM; d.w13add = 128; } \
        else if ((r -= I_C1) < I_D) { d.W = inp(F, I_FW2) + (size_t)l * DFF * DM; d.WT = wsp<h16>(F, WS_W2); d.N = DM; d.ldd = DFF; d.w13add = -1; } \
        else { r -= I_D; d.W = inp(F, I_GLUW) + (size_t)l * DG * DG; d.WT = wsp<h16>(F, WS_GLU); d.N = DG; d.ldd = DG; d.w13add = -1; } \
        const int nblk = d.N / 32; d.k0 = 64 * (r / nblk); d.n0 = 32 * (r % nblk); } while (0)
    if (parts & 3) { int it = it_lo + gwp; TrDesc dA, dB; f32x4 vA[8], vB[8];
        if (it < it_hi) { TR_DESC(dA, it); tr_load(dA, lane, vA); }
        while (it < it_hi) {
            const int it2 = it + NWP; if (it2 < it_hi) { TR_DESC(dB, it2); tr_load(dB, lane, vB); }
            tr_store(dA, lane, vA, scr);
            if (it2 >= it_hi) break;
            const int it3 = it2 + NWP; if (it3 < it_hi) { TR_DESC(dA, it3); tr_load(dA, lane, vA); }
            tr_store(dB, lane, vB, scr);
            it = it3; } }
#undef TR_DESC
    if (!(parts & 4)) return;
    const size_t gt = (size_t)gwp * 64 + lane, GT = (size_t)NWP * 64;
    { h16* LRT = wsp<h16>(F, WS_LRT); const float* w2 = inp(F, I_RWW2) + (size_t)l * 64 * DG; const float* a2 = inp(F, I_RWA2) + (size_t)l * 64 * DG; const float* g2 = inp(F, I_RWG2) + (size_t)l * 128 * DG;
        for (size_t i = gt; i < (size_t)1536 * 256; i += GT) { const int n = (int)(i >> 8), k = (int)(i & 255); float v = 0.f;
            if (n < 512) { if (k < 64) v = w2[k * DG + n]; }
            else if (n < 1024) { if (k >= 64 && k < 128) v = a2[(k - 64) * DG + (n - 512)]; }
            else { if (k >= 128) v = g2[(k - 128) * DG + (n - 1024)]; }
            LRT[i] = (h16)v; } }
    const float* cre = inp(F, I_S5CRE) + (size_t)l * 32768; const float* cim = inp(F, I_S5CIM) + (size_t)l * 32768;
    const float* LPW = wsp<float>(F, WS_LPW); const float* BBR = wsp<float>(F, WS_BBR);
    h16* T3 = wsp<h16>(F, WS_S5T3); h16* T1 = wsp<h16>(F, WS_S5T1);
    for (int un = gwp; un < 32 * 16 * 8; un += NWP) { const int g = un >> 7, c = (un >> 3) & 15, cp = 2 * (un & 7) + (lane >> 5), d = lane & 31; float kv = 0.f;
#pragma unroll 16
        for (int p = 0; p < 64; ++p) { const f32x2 lp = *(const f32x2*)(LPW + ((size_t)(g * 64 + p) * 33 + d) * 2), bb = *(const f32x2*)(BBR + ((size_t)(g * 64 + p) * 16 + cp) * 2);
            const float mr = lp.x * bb.x - lp.y * bb.y, mi = lp.x * bb.y + lp.y * bb.x;
            kv += cre[(g * 16 + c) * 64 + p] * mr - cim[(g * 16 + c) * 64 + p] * mi; }
        const h16 hv = (h16)kv;
        for (int t = 0; t < 32; ++t) { h16* rowp = T3 + ((size_t)g * 512 + t * 16 + c) * S5K3 + cp;
            if (t - d >= 0) rowp[(t - d) * 16] = hv;
            if (d > 0 && t + d < 32) rowp[(t + d) * 16] = (h16)0.f; }
    }
    for (size_t i0 = gt; i0 < (size_t)32 * 512 * 128; i0 += 4 * GT) { f32x2 lp[4]; float cr[4], ci[4];
#pragma unroll
        for (int u = 0; u < 4; ++u) { const size_t i = i0 + u * GT; const int n = (int)(i & 127), tc = (int)((i >> 7) & 511), g = (int)(i >> 16) & 31; const int t = tc >> 4, c = tc & 15, p = n & 63;
            lp[u] = *(const f32x2*)(LPW + ((size_t)(g * 64 + p) * 33 + t + 1) * 2); cr[u] = cre[(g * 16 + c) * 64 + p]; ci[u] = cim[(g * 16 + c) * 64 + p]; }
#pragma unroll
        for (int u = 0; u < 4; ++u) { const size_t i = i0 + u * GT; if (i < (size_t)32 * 512 * 128) { const int n = (int)(i & 127), tc = (int)((i >> 7) & 511), g = (int)(i >> 16);
            const float v = n < 64 ? (cr[u] * lp[u].x - ci[u] * lp[u].y) : -(cr[u] * lp[u].y + ci[u] * lp[u].x);
            T3[((size_t)g * 512 + tc) * S5K3 + 512 + n] = (h16)v; } } }
    for (size_t i0 = gt; i0 < (size_t)32 * 256 * 512; i0 += 4 * GT) { f32x2 lp[4], bb[4];
#pragma unroll
        for (int u = 0; u < 4; ++u) { const size_t i = i0 + u * GT; const int sc = (int)(i & 511), n = (int)((i >> 9) & 255), g = (int)(i >> 17) & 31; const int p = n & 63, s2 = sc >> 4, c = sc & 15;
            lp[u] = *(const f32x2*)(LPW + ((size_t)(g * 64 + p) * 33 + 31 - s2) * 2); bb[u] = *(const f32x2*)(BBR + ((size_t)(g * 64 + p) * 16 + c) * 2); }
#pragma unroll
        for (int u = 0; u < 4; ++u) { const size_t i = i0 + u * GT; if (i < (size_t)32 * 256 * 512) { const int n = (int)((i >> 9) & 255);
            const float v = n >= 128 ? 0.f : (n < 64 ? (lp[u].x * bb[u].x - lp[u].y * bb[u].y) : (lp[u].x * bb[u].y + lp[u].y * bb[u].x));
            T1[i] = (h16)v; } } }
}

DI void p0_mod(const Frame& F) { PHASE_IDS
    LAS float* cact = (LAS float*)F.lds;
    LAS float* red = (LAS float*)(F.lds + 65536);
    for (int i = tid; i < BATCH * DM; i += 512) cact[i] = siluf_(inp(F, I_C)[i]);
    __syncthreads();
    float* MOD = wsp<float>(F, WS_MOD);
    const int ks = tid >> 6, col = tid & 63;
    for (int un = bid; un < DEPTH * (MODW / 64); un += G) { const int l = un / (MODW / 64), cb = un % (MODW / 64);
        const float* w = inp(F, I_ADAW) + (size_t)l * DM * MODW + cb * 64 + col; float a[8] = {0, 0, 0, 0, 0, 0, 0, 0};
        for (int k = ks * 256; k < ks * 256 + 256; ++k) { const float wv = w[(size_t)k * MODW];
#pragma unroll
            for (int b = 0; b < 8; ++b) a[b] += cact[b * DM + k] * wv; }
#pragma unroll
        for (int b = 0; b < 8; ++b) red[(ks * 8 + b) * 64 + col] = a[b];
        __syncthreads();
        { const int b = tid >> 6; float s = 0.f;
#pragma unroll
            for (int k2 = 0; k2 < 8; ++k2) s += red[(k2 * 8 + b) * 64 + col];
            MOD[((size_t)l * BATCH + b) * MODW + cb * 64 + col] = s + inp(F, I_ADAB)[l * MODW + cb * 64 + col]; }
        __syncthreads();
    }
    if (bid == 0) { float* LB = wsp<float>(F, WS_LB); const int c = tid; const float* lg = inp(F, I_HGLB);
        const float v0 = lg[c], v1 = lg[512 + c], v2 = lg[1024 + c], v3 = lg[1536 + c]; const float mx = fmaxf(fmaxf(v0, v1), fmaxf(v2, v3));
        const float e0 = __expf(v0 - mx), e1 = __expf(v1 - mx), e2 = __expf(v2 - mx), e3 = __expf(v3 - mx), inv = __builtin_amdgcn_rcpf(e0 + e1 + e2 + e3);
        LB[c] = 0.f; LB[512 + c] = e1 * inv; LB[1024 + c] = (e1 + e2) * inv; LB[1536 + c] = (e1 + e2 + e3) * inv; }
    __syncthreads();
}
DI void modulate_rows(const Frame& F, const float* x, const float* modl, int shift_idx, h16* H) { PHASE_IDS
    for (int row = gw; row < M; row += NGW) { const int b = row >> 12; const float* sh = modl + (size_t)b * MODW + shift_idx * DM; const float* sc = sh + DM;
#pragma unroll
        for (int j = 0; j < 4; ++j) { const int c = j * 512 + lane * 8; const f32x4 x0 = *(const f32x4*)(x + (size_t)row * DM + c), x1 = *(const f32x4*)(x + (size_t)row * DM + c + 4);
            const f32x4 s0 = *(const f32x4*)(sc + c), s1 = *(const f32x4*)(sc + c + 4), h0 = *(const f32x4*)(sh + c), h1 = *(const f32x4*)(sh + c + 4);
            const f32x4 y0 = x0 * (1.f + s0) + h0, y1 = x1 * (1.f + s1) + h1;
            u32x4 w; w.x = pkh(y0[0], y0[1]); w.y = pkh(y0[2], y0[3]); w.z = pkh(y1[0], y1[1]); w.w = pkh(y1[2], y1[3]);
            *(u32x4*)(H + (size_t)row * DM + c) = w; } }
}
DI void ln_rows(const Frame& F, const h16* xi, float* xo, const float* g, const float* bta, const float* modn, int shift_idx, h16* H, float* stat) { PHASE_IDS
    for (int rb = gw * 16; rb < M; rb += NGW * 16) { const int b = rb >> 12;
        f32x4 Gp[8], Bp[8];
#pragma unroll
        for (int j = 0; j < 8; ++j) { const int c = (j >> 1) * 512 + lane * 8 + (j & 1) * 4; const f32x4 gv = *(const f32x4*)(g + c), bv = *(const f32x4*)(bta + c);
            if (H) { const float* sh = modn + (size_t)b * MODW + shift_idx * DM; const f32x4 sc1 = 1.f + *(const f32x4*)(sh + DM + c); Gp[j] = gv * sc1; Bp[j] = bv * sc1 + *(const f32x4*)(sh + c); }
            else { Gp[j] = gv; Bp[j] = bv; } }
        for (int r2 = 0; r2 < 16; r2 += 2) { half8 raw[2][4];
#pragma unroll
            for (int u = 0; u < 2; ++u)
#pragma unroll
                for (int j = 0; j < 4; ++j) raw[u][j] = *(const half8*)(xi + (size_t)(rb + r2 + u) * DM + j * 512 + lane * 8);
            __builtin_amdgcn_sched_barrier(0);
#pragma unroll
            for (int u = 0; u < 2; ++u) { const int row = rb + r2 + u; float s = 0.f; f32x4 v[8];
#pragma unroll
                for (int j = 0; j < 4; ++j) { v[2 * j] = (f32x4){(float)raw[u][j][0], (float)raw[u][j][1], (float)raw[u][j][2], (float)raw[u][j][3]}; v[2 * j + 1] = (f32x4){(float)raw[u][j][4], (float)raw[u][j][5], (float)raw[u][j][6], (float)raw[u][j][7]}; }
#pragma unroll
                for (int j = 0; j < 8; ++j) s += (v[j][0] + v[j][1]) + (v[j][2] + v[j][3]);
                const float mean = wave_sum(s) * (1.f / DM); float q = 0.f;
#pragma unroll
                for (int j = 0; j < 8; ++j) { v[j] = v[j] - mean; q += (v[j][0] * v[j][0] + v[j][1] * v[j][1]) + (v[j][2] * v[j][2] + v[j][3] * v[j][3]); }
                const float rstd = rsqrtf_(wave_sum(q) * (1.f / DM) + opq_f(LN_EPS));
                if (stat && lane == 0) *(f32x2*)(stat + 2 * (size_t)row) = (f32x2){mean, rstd};
#pragma unroll
                for (int j = 0; j < 4; ++j) { const int c = j * 512 + lane * 8; const f32x4 y0 = v[2 * j] * rstd * Gp[2 * j] + Bp[2 * j], y1 = v[2 * j + 1] * rstd * Gp[2 * j + 1] + Bp[2 * j + 1];
                    if (H) { u32x4 w; w.x = pkh(y0[0], y0[1]); w.y = pkh(y0[2], y0[3]); w.z = pkh(y1[0], y1[1]); w.w = pkh(y1[2], y1[3]); *(u32x4*)(H + (size_t)row * DM + c) = w; }
                    else { *(f32x4*)(xo + (size_t)row * DM + c) = y0; *(f32x4*)(xo + (size_t)row * DM + c + 4) = y1; } } } }
    }
}
DI void prep_rows(const Frame& F, int l) { PHASE_IDS
    const h16* P = wsp<h16>(F, WS_PROJ); h16* RWA = wsp<h16>(F, WS_RWA);
    const float* mu = inp(F, I_RWMU) + l * 1792;
    float mu4[4];
#pragma unroll
    for (int j = 0; j < 4; ++j) mu4[j] = mu[1536 + 4 * lane + j];
    for (int row0 = gw; row0 < M; row0 += 4 * NGW) { half4 cur[4], prv[4];
#pragma unroll
        for (int u = 0; u < 4; ++u) { const int row = row0 + u * NGW; const int rowc = row < M ? row : M - 1; const int t = rowc & (SEQ - 1); const h16* pr = P + (size_t)rowc * NIN;
            cur[u] = *(const half4*)(pr + RWOFF + 1536 + 4 * lane); prv[u] = *(const half4*)(pr - (t > 0 ? NIN : 0) + RWOFF + 1536 + 4 * lane); if (t == 0) prv[u] = (half4){0, 0, 0, 0}; }
#pragma unroll
        for (int u = 0; u < 4; ++u) { const int row = row0 + u * NGW; if (row < M) { float o[4];
#pragma unroll
            for (int j = 0; j < 4; ++j) { const float cv = (float)cur[u][j], sv = cv + mu4[j] * ((float)prv[u][j] - cv); o[j] = lane < 16 ? tanhf_(sv) : (lane < 32 ? sv : sigmoidf_(sv)); }
            u32x2 w; w.x = pkh(o[0], o[1]); w.y = pkh(o[2], o[3]); *(u32x2*)(RWA + (size_t)row * 256 + 4 * lane) = w; } }
    }
}
constexpr int RR_KH = 0, RR_RH = 2304, RR_BT = 4608, RR_KT = 6656, RR_VV = 8704, RR_TT = 10752, RR_A3 = 11264, RR_A2 = 11776, RR_A4 = 12288, RR_GL = 12800, RR_BYTES = 13312, RR_P = 72;
DI float wave_sum_all(float v) { v = sum16(v);
    const int iv = __builtin_bit_cast(int, v);
    return (__builtin_bit_cast(float, __builtin_amdgcn_readlane(iv, 0)) + __builtin_bit_cast(float, __builtin_amdgcn_readlane(iv, 16))) + (__builtin_bit_cast(float, __builtin_amdgcn_readlane(iv, 32)) + __builtin_bit_cast(float, __builtin_amdgcn_readlane(iv, 48))); }
DI void rwkv_chunk_prep(const Frame& F, int l) { PHASE_IDS
    const h16* P = wsp<h16>(F, WS_PROJ); const h16* LR = wsp<h16>(F, WS_LR16); unsigned char* REC = wsp<unsigned char>(F, WS_RWREC); float* BON = wsp<float>(F, WS_RWBON);
    LAS unsigned short* L = (LAS unsigned short*)(F.lds + wave * 16384);
    LAS float* A1L = (LAS float*)(F.lds + wave * 16384 + 4 * 16 * RR_P * 2);
    const float* mu = inp(F, I_RWMU) + l * 1792;
    const int k = lane, rr = lane & 15, q = lane >> 4;
    const int kperm = (k & 32) + 8 * ((k >> 2) & 3) + 4 * ((k >> 4) & 1) + (k & 3);
    int hprev = -1; float mur = 0.f, muk = 0.f, muv = 0.f, kk_ = 0.f, ka_ = 0.f, rk_ = 0.f, w0_ = 0.f, a0_ = 0.f;
    for (int cu = gw; cu < BATCH * 8 * 256; cu += NGW) { const int c = cu & 255, bh = cu >> 8, b = bh >> 3, h = bh & 7, col = h * 64 + k;
        const size_t t0 = (size_t)b * SEQ + 16 * c; unsigned char* rec = REC + (size_t)cu * RR_BYTES;
        if (h != hprev) { hprev = h;
            mur = mu[col]; muk = mu[512 + col]; muv = mu[1024 + col]; kk_ = inp(F, I_RWKK)[l * DG + col]; ka_ = inp(F, I_RWKA)[l * DG + col]; rk_ = inp(F, I_RWRK)[l * DG + col];
            w0_ = inp(F, I_RWW0)[l * DG + col]; a0_ = inp(F, I_RWA0)[l * DG + col]; }
        float rp = 0.f, kp_ = 0.f, vp = 0.f;
        if (c > 0) { const h16* pp = P + (t0 - 1) * NIN + RWOFF + col; rp = (float)pp[0]; kp_ = (float)pp[512]; vp = (float)pp[1024]; }
        float G = 1.f, bcv[16], kcv[16];
        h16 rin[16], kin[16], vin[16], zwin[16], zain[16];
#pragma unroll
        for (int jj = 0; jj < 16; ++jj) { const h16* pr = P + (t0 + jj) * NIN + RWOFF + col; rin[jj] = pr[0]; kin[jj] = pr[512]; vin[jj] = pr[1024]; zwin[jj] = LR[(t0 + jj) * 1536 + col]; zain[jj] = LR[(t0 + jj) * 1536 + 512 + col]; }
        __builtin_amdgcn_sched_barrier(0);
#pragma unroll
        for (int jj = 0; jj < 16; ++jj) { const float rc = (float)rin[jj], kc = (float)kin[jj], vc = (float)vin[jj];
            const float r = rc + mur * (rp - rc), kx = kc + muk * (kp_ - kc), vx = vc + muv * (vp - vc); rp = rc; kp_ = kc; vp = vc;
            const float a = sigmoidf_((float)zain[jj] + a0_), wd = __expf(-0.6065306597126334f * sigmoidf_((float)zwin[jj] + w0_));
            const float kkr = kx * kk_; const float n2 = wave_sum_all(kkr * kkr); const float kap = kkr * rsqrtf_(fmaxf(n2, 1e-24f));
            const float kpr = kx * (1.f + (a - 1.f) * ka_); const float bs = wave_sum_all(r * kpr * rk_);
            if (lane == 0) BON[(t0 + jj) * 8 + h] = bs;
            const float Gm = G; G *= wd; const float rg = __builtin_amdgcn_rcpf(G);
            const unsigned short khb = f2bf(kap * Gm), rhb = f2bf(r * G); bcv[jj] = kap * a * rg; kcv[jj] = kpr * rg;
            *(unsigned short*)(rec + RR_KH + (jj * RR_P + kperm) * 2) = khb; *(unsigned short*)(rec + RR_RH + (jj * RR_P + kperm) * 2) = rhb;
            *(unsigned short*)(rec + RR_VV + (jj * 64 + k) * 2) = f2bf(vx);
            L[jj * RR_P + k] = khb; L[(16 + jj) * RR_P + k] = rhb; L[(32 + jj) * RR_P + k] = f2bf(bcv[jj]); L[(48 + jj) * RR_P + k] = f2bf(kcv[jj]); }
        { u32x4 b0, b1, k0, k1;
#define PK2(x, y) ((unsigned)f2bf(x) | ((unsigned)f2bf(y) << 16))
            b0.x = PK2(-bcv[0], -bcv[1]); b0.y = PK2(-bcv[2], -bcv[3]); b0.z = PK2(-bcv[4], -bcv[5]); b0.w = PK2(-bcv[6], -bcv[7]); b1.x = PK2(-bcv[8], -bcv[9]); b1.y = PK2(-bcv[10], -bcv[11]); b1.z = PK2(-bcv[12], -bcv[13]); b1.w = PK2(-bcv[14], -bcv[15]);
            k0.x = PK2(kcv[0], kcv[1]); k0.y = PK2(kcv[2], kcv[3]); k0.z = PK2(kcv[4], kcv[5]); k0.w = PK2(kcv[6], kcv[7]); k1.x = PK2(kcv[8], kcv[9]); k1.y = PK2(kcv[10], kcv[11]); k1.z = PK2(kcv[12], kcv[13]); k1.w = PK2(kcv[14], kcv[15]);
            *(u32x4*)(rec + RR_BT + k * 32) = b0; *(u32x4*)(rec + RR_BT + k * 32 + 16) = b1; *(u32x4*)(rec + RR_KT + k * 32) = k0; *(u32x4*)(rec + RR_KT + k * 32 + 16) = k1;
            *(float*)(rec + RR_GL + k * 4) = G; }
        asm volatile("s_waitcnt lgkmcnt(0)" ::: "memory");
        f32x4 A1 = {0.f, 0.f, 0.f, 0.f}, A2 = A1, A3 = A1, A4 = A1;
#pragma unroll
        for (int ks = 0; ks < 2; ++ks) { const int off = rr * RR_P + 32 * ks + 8 * q;
            const bf16x8 fkh = *(const LAS bf16x8*)(L + off), frh = *(const LAS bf16x8*)(L + 16 * RR_P + off), fbc = *(const LAS bf16x8*)(L + 32 * RR_P + off), fkc = *(const LAS bf16x8*)(L + 48 * RR_P + off);
            A1 = __builtin_amdgcn_mfma_f32_16x16x32_bf16(fbc, fkh, A1, 0, 0, 0); A2 = __builtin_amdgcn_mfma_f32_16x16x32_bf16(fkc, fkh, A2, 0, 0, 0);
            A3 = __builtin_amdgcn_mfma_f32_16x16x32_bf16(fbc, frh, A3, 0, 0, 0); A4 = __builtin_amdgcn_mfma_f32_16x16x32_bf16(fkc, frh, A4, 0, 0, 0); }
        { u32x2 w3, w2, w4; float m3[4], m2[4], m4[4];
#pragma unroll
            for (int i2 = 0; i2 < 4; ++i2) { const int sidx = 4 * q + i2; const bool lt = sidx < rr, le = sidx <= rr;
                A1L[sidx * 16 + rr] = lt ? A1[i2] : 0.f; m2[i2] = lt ? A2[i2] : 0.f; m3[i2] = le ? -A3[i2] : 0.f; m4[i2] = le ? A4[i2] : 0.f; }
            w3.x = PK2(m3[0], m3[1]); w3.y = PK2(m3[2], m3[3]); w2.x = PK2(m2[0], m2[1]); w2.y = PK2(m2[2], m2[3]); w4.x = PK2(m4[0], m4[1]); w4.y = PK2(m4[2], m4[3]);
            *(u32x2*)(rec + RR_A3 + (rr * 16 + 4 * q) * 2) = w3; *(u32x2*)(rec + RR_A2 + (rr * 16 + 4 * q) * 2) = w2; *(u32x2*)(rec + RR_A4 + (rr * 16 + 4 * q) * 2) = w4; }
        asm volatile("s_waitcnt lgkmcnt(0)" ::: "memory");
        { float x[16];
#pragma unroll
            for (int sidx = 15; sidx >= 0; --sidx) { float acc = (sidx == rr) ? 1.f : 0.f;
#pragma unroll
                for (int s2 = sidx + 1; s2 < 16; ++s2) acc -= A1L[sidx * 16 + s2] * x[s2];
                x[sidx] = acc; }
            if (lane < 16) { u32x4 t0v, t1v; t0v.x = PK2(x[0], x[1]); t0v.y = PK2(x[2], x[3]); t0v.z = PK2(x[4], x[5]); t0v.w = PK2(x[6], x[7]); t1v.x = PK2(x[8], x[9]); t1v.y = PK2(x[10], x[11]); t1v.z = PK2(x[12], x[13]); t1v.w = PK2(x[14], x[15]);
                *(u32x4*)(rec + RR_TT + lane * 32) = t0v; *(u32x4*)(rec + RR_TT + lane * 32 + 16) = t1v; } }
#undef PK2
        asm volatile("s_waitcnt lgkmcnt(0)" ::: "memory");
    }
}
DI void s5_chunk_scan(const Frame& F, int l) { PHASE_IDS
    const float* HL = wsp<float>(F, WS_HLOC); h16* UG = wsp<h16>(F, WS_UG);
    const float* are = inp(F, I_S5ARE) + l * 2048; const float* aim = inp(F, I_S5AIM) + l * 2048; const float* ldt = inp(F, I_S5LDT) + l * 32;
    for (int un = gw; un < 32 * BATCH; un += NGW) { const int g = un >> 3, b = un & 7, p = lane;
        S5Par sp{are[g * 64 + p], aim[g * 64 + p], __expf(ldt[g])}; float Lr, Li; s5_lampow(sp, S5L, Lr, Li);
        float hr = 0.f, hi = 0.f; const size_t base = (size_t)g * S5NC + b * 128;
        for (int c0 = 0; c0 < 128; c0 += 32) { float xr[32], xi[32];
#pragma unroll
            for (int j = 0; j < 32; ++j) { xr[j] = HL[(base + c0 + j) * 128 + p]; xi[j] = HL[(base + c0 + j) * 128 + 64 + p]; }
            __builtin_amdgcn_sched_barrier(0);
#pragma unroll
            for (int j = 0; j < 32; ++j) { h16* dst = UG + (base + c0 + j) * S5K3 + 512; dst[p] = (h16)hr; dst[64 + p] = (h16)hi;
                const float nr = Lr * hr - Li * hi + xr[j], ni = Lr * hi + Li * hr + xi[j]; hr = nr; hi = ni; } }
    }
}

typedef float f32x16 __attribute__((ext_vector_type(16)));
DI void attention_units(const Frame& F, int ws, int nwb) { PHASE_IDS
    const int NWP = G * nwb, gwp = NWP - 1 - (bid * nwb + ws);
    const h16* P = wsp<h16>(F, WS_PROJ); h16* MIX = wsp<h16>(F, WS_H16);
    const int r = lane & 31, hh = lane >> 5;
    for (int un = gwp; un < BATCH * 4 * (SEQ / 32); un += NWP) { const int qt = un & 127, bh = un >> 7, b = bh >> 2, h = bh & 3, t0 = 32 * qt;
        const size_t tokb = (size_t)b * SEQ;
        half8 qf[8];
#pragma unroll
        for (int s8 = 0; s8 < 8; ++s8) qf[s8] = *(const half8*)(P + (tokb + t0 + r) * NIN + 2560 + h * 128 + 16 * s8 + 8 * hh);
        f32x16 oacc[4];
#pragma unroll
        for (int mt = 0; mt < 4; ++mt)
#pragma unroll
            for (int i2 = 0; i2 < 16; ++i2) oacc[mt][i2] = 0.f;
        float run = 0.f;
        for (int k0 = t0; k0 >= 0; k0 -= 32) {
            f32x16 sacc;
#pragma unroll
            for (int i2 = 0; i2 < 16; ++i2) sacc[i2] = 0.f;
            const h16* kr = P + (tokb + k0 + r) * NIN + 3072 + h * 128 + 8 * hh; const h16* vr = P + (tokb + k0 + 4 * hh) * NIN + 3584 + h * 128 + 4 * r;
            half8 kfa[8]; half4 vqa[16];
#pragma unroll
            for (int s8 = 0; s8 < 8; ++s8) kfa[s8] = *(const half8*)(kr + 16 * s8);
#pragma unroll
            for (int jj = 0; jj < 16; ++jj) vqa[jj] = *(const half4*)(vr + (size_t)(16 * (jj >> 3) + 8 * ((jj >> 2) & 1) + (jj & 3)) * NIN);
            __builtin_amdgcn_sched_barrier(0);
#pragma unroll
            for (int s8 = 0; s8 < 8; ++s8) sacc = __builtin_amdgcn_mfma_f32_32x32x16_f16(kfa[s8], qf[s8], sacc, 0, 0, 0);
            const bool diag = (k0 == t0);
            float ls[16], zz[16];
#pragma unroll
            for (int i2 = 0; i2 < 16; ++i2) { const int kc = (i2 & 3) + 8 * (i2 >> 2) + 4 * hh; const bool valid = !diag || (kc < r);
                zz[i2] = sacc[i2] * 0.08838834764831845f; ls[i2] = valid ? -softplusf_(zz[i2]) : 0.f; }
            float Gs[4], Ps[4];
#pragma unroll
            for (int g = 0; g < 4; ++g) { Gs[g] = (ls[4 * g] + ls[4 * g + 1]) + (ls[4 * g + 2] + ls[4 * g + 3]); Ps[g] = __shfl_xor(Gs[g], 32); }
            float later = 0.f, T[4];
#pragma unroll
            for (int g = 3; g >= 0; --g) { T[g] = later + (hh == 0 ? Ps[g] : 0.f); later += Gs[g] + Ps[g]; }
            half8 wf[2];
#pragma unroll
            for (int g = 0; g < 4; ++g) { float af[4]; af[3] = run + T[g]; af[2] = af[3] + ls[4 * g + 3]; af[1] = af[2] + ls[4 * g + 2]; af[0] = af[1] + ls[4 * g + 1];
#pragma unroll
                for (int e = 0; e < 4; ++e) { const int i2 = 4 * g + e; const int kc = (i2 & 3) + 8 * (i2 >> 2) + 4 * hh; const bool valid = !diag || (kc < r);
                    const float w = valid ? __expf(zz[i2] + ls[i2] + af[e]) : 0.f; wf[g >> 1][4 * (g & 1) + e] = (h16)w; } }
            run += later;
#pragma unroll
            for (int s2 = 0; s2 < 2; ++s2) { half8 vf[4];
#pragma unroll
                for (int jj = 0; jj < 8; ++jj) { const half4 v4 = vqa[8 * s2 + jj]; vf[0][jj] = v4[0]; vf[1][jj] = v4[1]; vf[2][jj] = v4[2]; vf[3][jj] = v4[3]; }
#pragma unroll
                for (int mt = 0; mt < 4; ++mt) oacc[mt] = __builtin_amdgcn_mfma_f32_32x32x16_f16(vf[mt], wf[s2], oacc[mt], 0, 0, 0); }
            if (__builtin_amdgcn_ballot_w64(run >= -110.f) == 0ull) break;
        }
        h16* orow = MIX + (tokb + t0 + r) * DM + 1024 + h * 128;
#pragma unroll
        for (int i2 = 0; i2 < 16; ++i2) { const int m = (i2 & 3) + 8 * (i2 >> 2) + 4 * hh; u32x2 w; w.x = pkh(oacc[0][i2], oacc[1][i2]); w.y = pkh(oacc[2][i2], oacc[3][i2]);
            *(u32x2*)(orow + 4 * m) = w; }
    }
}

typedef __bf16 bfv4 __attribute__((ext_vector_type(4)));
DI bf16x4 pack4bf(const f32x4 v) { return __builtin_bit_cast(bf16x4, __builtin_convertvector(v, bfv4)); }
DI bf16x8 cat8(const bf16x4 a, const bf16x4 b) { bf16x8 r; r[0] = a[0]; r[1] = a[1]; r[2] = a[2]; r[3] = a[3]; r[4] = b[0]; r[5] = b[1]; r[6] = b[2]; r[7] = b[3]; return r; }
constexpr int RW_NSLOT = 9, RW_SYNC_OFF = MISC_OFF + 128;
DI void rwkv_sync_zero(const Frame& F) { volatile LAS unsigned* sy = (volatile LAS unsigned*)(F.lds + RW_SYNC_OFF); if (F.wave == 0 && opq_lane() == 0) { sy[0] = 0u; sy[1] = 0u; sy[2] = 0u; } }
DI void rwkv_scan_loader(const Frame& F, int w) { PHASE_IDS
    volatile LAS unsigned* sy = (volatile LAS unsigned*)(F.lds + RW_SYNC_OFF);
    const unsigned ring = (unsigned)(size_t)F.lds;
    int ui = 0;
    for (int un = bid; un < 256; un += G, ++ui) { const int bh = un >> 2;
        const unsigned char* REC = wsp<unsigned char>(F, WS_RWREC) + (size_t)bh * 256 * RR_BYTES;
        for (int i2 = 0; i2 < 128; ++i2) { const int c = 2 * i2 + w, gc = ui * 256 + c;
            for (unsigned sp = 0; (int)(gc - (int)sy[2]) >= RW_NSLOT && sp < (1u << 22); ++sp) __builtin_amdgcn_s_sleep(2);
            const char* src = (const char*)(REC + (size_t)c * RR_BYTES); const unsigned dst = ring + (unsigned)((gc % RW_NSLOT) * RR_BYTES);
#pragma unroll
            for (int p = 0; p < 13; ++p) pg8::glds16_s(src + p * 1024, (unsigned)lane * 16u, dst + p * 1024u);
            if (i2 >= 3) { asm volatile("s_waitcnt vmcnt(39)" ::: "memory"); if (lane == 0) sy[w] = (unsigned)(ui * 128 + i2 - 2); }
        }
        asm volatile("s_waitcnt vmcnt(0)" ::: "memory"); if (lane == 0) sy[w] = (unsigned)(ui * 128 + 128);
    }
}
DI void rwkv_scan_consumer(const Frame& F) { PHASE_IDS
    volatile LAS unsigned* sy = (volatile LAS unsigned*)(F.lds + RW_SYNC_OFF);
    const int rr = lane & 15, q = lane >> 4; const int q1 = q & 1; const bool qlo = q < 2;
    const bf16x4 z4 = {0, 0, 0, 0}; const bf16x8 z8 = {0, 0, 0, 0, 0, 0, 0, 0};
    int ui = 0;
    for (int un = bid; un < 256; un += G, ++ui) { const int vq = un & 3, bh = un >> 2, b = bh >> 3, h = bh & 7;
        __attribute__((address_space(1))) h16* RAW = (__attribute__((address_space(1))) h16*)(wsp<h16>(F, WS_RWRAW) + (size_t)b * SEQ * DG + h * 64 + 16 * vq + rr);
        f32x4 ST[4];
#pragma unroll
        for (int kt = 0; kt < 4; ++kt) ST[kt] = (f32x4){0.f, 0.f, 0.f, 0.f};
        for (int c = 0; c < 256; ++c) { const int gc = ui * 256 + c; const unsigned need = (unsigned)(ui * 128 + (c >> 1) + 1);
            for (unsigned sp = 0; sy[c & 1] < need && sp < (1u << 22); ++sp) __builtin_amdgcn_s_sleep(1);
            const LAS unsigned char* sl = F.lds + (gc % RW_NSLOT) * RR_BYTES;
            bf16x8 khf[2], rhf[2], ktf[4], a2f, a4f, ttf, a3f, btf[4], vB; f32x4 gl[4];
#pragma unroll
            for (int ks = 0; ks < 2; ++ks) { khf[ks] = *(const LAS bf16x8*)(sl + RR_KH + (rr * RR_P + 32 * ks + 8 * q) * 2); rhf[ks] = *(const LAS bf16x8*)(sl + RR_RH + (rr * RR_P + 32 * ks + 8 * q) * 2); }
            a2f = *(const LAS bf16x8*)(sl + RR_A2 + (rr * 16 + 8 * q1) * 2); a4f = *(const LAS bf16x8*)(sl + RR_A4 + (rr * 16 + 8 * q1) * 2);
            ttf = cat8(*(const LAS bf16x4*)(sl + RR_TT + (rr * 16 + 4 * q) * 2), z4); a3f = cat8(*(const LAS bf16x4*)(sl + RR_A3 + (rr * 16 + 4 * q) * 2), z4);
#pragma unroll
            for (int kt = 0; kt < 4; ++kt) { btf[kt] = cat8(*(const LAS bf16x4*)(sl + RR_BT + ((16 * kt + rr) * 16 + 4 * q) * 2), z4);
                ktf[kt] = *(const LAS bf16x8*)(sl + RR_KT + ((16 * kt + rr) * 16 + 8 * q1) * 2); gl[kt] = *(const LAS f32x4*)(sl + RR_GL + (16 * kt + 4 * q) * 4); }
#pragma unroll
            for (int jj = 0; jj < 8; ++jj) vB[jj] = *(const LAS short*)(sl + RR_VV + ((8 * q1 + jj) * 64 + 16 * vq + rr) * 2);
            asm volatile("s_waitcnt lgkmcnt(0)" ::: "memory");
            __builtin_amdgcn_sched_barrier(0);
            if (lane == 0) sy[2] = (unsigned)(gc + 1);
            a2f = qlo ? a2f : z8; a4f = qlo ? a4f : z8; vB = qlo ? vB : z8;
#pragma unroll
            for (int kt = 0; kt < 4; ++kt) ktf[kt] = qlo ? ktf[kt] : z8;
            const bf16x8 sb0 = cat8(pack4bf(ST[0]), pack4bf(ST[1])), sb1 = cat8(pack4bf(ST[2]), pack4bf(ST[3]));
            f32x4 acc = {0.f, 0.f, 0.f, 0.f};
            acc = __builtin_amdgcn_mfma_f32_16x16x32_bf16(a2f, vB, acc, 0, 0, 0); acc = __builtin_amdgcn_mfma_f32_16x16x32_bf16(khf[0], sb0, acc, 0, 0, 0); acc = __builtin_amdgcn_mfma_f32_16x16x32_bf16(khf[1], sb1, acc, 0, 0, 0);
            const bf16x8 rB = cat8(pack4bf(acc), z4);
            f32x4 e = {0.f, 0.f, 0.f, 0.f}; e = __builtin_amdgcn_mfma_f32_16x16x32_bf16(ttf, rB, e, 0, 0, 0);
            const bf16x8 eB = cat8(pack4bf(e), z4);
            f32x4 o = {0.f, 0.f, 0.f, 0.f};
            o = __builtin_amdgcn_mfma_f32_16x16x32_bf16(a4f, vB, o, 0, 0, 0); o = __builtin_amdgcn_mfma_f32_16x16x32_bf16(rhf[0], sb0, o, 0, 0, 0); o = __builtin_amdgcn_mfma_f32_16x16x32_bf16(rhf[1], sb1, o, 0, 0, 0);
            o = __builtin_amdgcn_mfma_f32_16x16x32_bf16(a3f, eB, o, 0, 0, 0);
#pragma unroll
            for (int kt = 0; kt < 4; ++kt) { f32x4 t = __builtin_amdgcn_mfma_f32_16x16x32_bf16(btf[kt], eB, ST[kt], 0, 0, 0); t = __builtin_amdgcn_mfma_f32_16x16x32_bf16(ktf[kt], vB, t, 0, 0, 0); ST[kt] = t * gl[kt]; }
#pragma unroll
            for (int i2 = 0; i2 < 4; ++i2) RAW[(size_t)(16 * c + 4 * q + i2) * DG] = (h16)o[i2];
        }
    }
}
DI void hgrn_prep(const Frame& F, int l) { PHASE_IDS
    const h16* P = wsp<h16>(F, WS_PROJ); unsigned short* KT = wsp<unsigned short>(F, WS_HGK); unsigned short* QT = wsp<unsigned short>(F, WS_HGQ); float* HB = wsp<float>(F, WS_HGB);
    const float lbc = 1.f - wsp<float>(F, WS_LB)[l * 512 + tid];
    for (int un = bid; un < BATCH * 64; un += G) { const size_t tok0 = (size_t)un * 64;
        float B = 0.f, Bmid = 0.f;
        for (int th = 0; th < 64; th += 32) { h16 zin[32];
#pragma unroll
            for (int t = 0; t < 32; ++t) zin[t] = P[(tok0 + th + t) * NIN + 512 + tid];
            __builtin_amdgcn_sched_barrier(0);
#pragma unroll
            for (int t = 0; t < 32; ++t) { const float k = lbc * sigmoidf_(-(float)zin[t]); B += 0.6931471805599453f * __builtin_amdgcn_logf(1.f - k); if (th + t == 31) Bmid = B; } }
        HB[(size_t)un * 1024 + tid] = Bmid; HB[(size_t)un * 1024 + 512 + tid] = B;
        B = 0.f;
        for (int th = 0; th < 64; th += 32) { h16 zin[32], qin[32];
#pragma unroll
            for (int t = 0; t < 32; ++t) { zin[t] = P[(tok0 + th + t) * NIN + 512 + tid]; qin[t] = P[(tok0 + th + t) * NIN + tid]; }
            __builtin_amdgcn_sched_barrier(0);
#pragma unroll
            for (int t = 0; t < 32; ++t) { const float z = (float)zin[t], qv = (float)qin[t]; const float k = lbc * sigmoidf_(-z);
                B += 0.6931471805599453f * __builtin_amdgcn_logf(1.f - k);
                QT[(tok0 + th + t) * DG + tid] = f2bf(siluf_(qv) * __expf(fminf(B - Bmid, 80.f))); KT[(tok0 + th + t) * DG + tid] = f2bf(k * __expf(fminf(Bmid - B, 80.f))); } }
    }
}
DI void hgrn_loc_units(const Frame& F) { PHASE_IDS
    const h16* P = wsp<h16>(F, WS_PROJ); const unsigned short* KT = wsp<unsigned short>(F, WS_HGK); unsigned short* ST = wsp<unsigned short>(F, WS_HGST); const float* HB = wsp<float>(F, WS_HGB);
    const int r = lane & 31, hh = lane >> 5;
    for (int un = gw; un < BATCH * 4 * 64 * 4; un += NGW) { const int mt = un & 3, bhc = un >> 2, c = bhc & 63, bh = bhc >> 6, b = bh >> 2, h = bh & 3;
        const size_t tok0 = ((size_t)b * 64 + c) * 64;
        f32x16 acc[4];
#pragma unroll
        for (int nt = 0; nt < 4; ++nt)
#pragma unroll
            for (int i2 = 0; i2 < 16; ++i2) acc[nt][i2] = 0.f;
        h16 vraw[4][8]; bf16x4 kraw[4][8];
#pragma unroll
        for (int s4 = 0; s4 < 4; ++s4)
#pragma unroll
            for (int jj = 0; jj < 8; ++jj) { const size_t tk = tok0 + 16 * s4 + 8 * hh + jj; vraw[s4][jj] = P[tk * NIN + 1024 + h * 128 + 4 * r + mt]; kraw[s4][jj] = *(const bf16x4*)(KT + tk * DG + h * 128 + 4 * r); }
        const float* hb = HB + ((size_t)b * 64 + c) * 1024 + h * 128 + 4 * r; const f32x4 bm = *(const f32x4*)hb, bl = *(const f32x4*)(hb + 512);
        __builtin_amdgcn_sched_barrier(0);
        bf16x8 afa[4], bfa[4][4];
#pragma unroll
        for (int s4 = 0; s4 < 4; ++s4)
#pragma unroll
            for (int jj = 0; jj < 8; ++jj) { afa[s4][jj] = (short)f2bf((float)vraw[s4][jj]); const bf16x4 k4 = kraw[s4][jj]; bfa[s4][0][jj] = k4[0]; bfa[s4][1][jj] = k4[1]; bfa[s4][2][jj] = k4[2]; bfa[s4][3][jj] = k4[3]; }
#pragma unroll
        for (int s4 = 0; s4 < 4; ++s4)
#pragma unroll
            for (int nt = 0; nt < 4; ++nt) acc[nt] = __builtin_amdgcn_mfma_f32_32x32x16_bf16(afa[s4], bfa[s4][nt], acc[nt], 0, 0, 0);
        float e[4];
#pragma unroll
        for (int nt = 0; nt < 4; ++nt) e[nt] = __expf(bl[nt] - bm[nt]);
        unsigned short* st = ST + (size_t)bhc * 16384 + 4 * r;
#pragma unroll
        for (int i2 = 0; i2 < 16; ++i2) { const int v = 4 * ((i2 & 3) + 8 * (i2 >> 2) + 4 * hh) + mt;
            u32x2 w; w.x = (unsigned)f2bf(acc[0][i2] * e[0]) | ((unsigned)f2bf(acc[1][i2] * e[1]) << 16); w.y = (unsigned)f2bf(acc[2][i2] * e[2]) | ((unsigned)f2bf(acc[3][i2] * e[3]) << 16);
            *(u32x2*)(st + (size_t)v * 128) = w; }
    }
}
DI void hgrn_state_scan(const Frame& F) { PHASE_IDS
    unsigned short* ST = wsp<unsigned short>(F, WS_HGST); const float* HB = wsp<float>(F, WS_HGB);
    for (int e0 = bid * 512 + tid; e0 < 32 * 4096; e0 += G * 512) { const int bh = e0 >> 12, rem = e0 & 4095, v = rem >> 5, k4 = (rem & 31) * 4, b = bh >> 2, h = bh & 3;
        float s0 = 0.f, s1 = 0.f, s2 = 0.f, s3 = 0.f;
        unsigned short* st = ST + (size_t)bh * 64 * 16384 + (size_t)v * 128 + k4; const float* hb = HB + (size_t)b * 64 * 1024 + h * 128 + k4;
        for (int c0 = 0; c0 < 64; c0 += 8) { u32x2 wv[8]; f32x4 bmv[8], blv[8];
#pragma unroll
            for (int j = 0; j < 8; ++j) { wv[j] = *(const u32x2*)(st + (size_t)(c0 + j) * 16384); bmv[j] = *(const f32x4*)(hb + (size_t)(c0 + j) * 1024); blv[j] = *(const f32x4*)(hb + (size_t)(c0 + j) * 1024 + 512); }
            __builtin_amdgcn_sched_barrier(0);
#pragma unroll
            for (int j = 0; j < 8; ++j) { const u32x2 w = wv[j]; const f32x4 bm = bmv[j], bl = blv[j];
                u32x2 o; o.x = (unsigned)f2bf(s0 * __expf(bm[0])) | ((unsigned)f2bf(s1 * __expf(bm[1])) << 16); o.y = (unsigned)f2bf(s2 * __expf(bm[2])) | ((unsigned)f2bf(s3 * __expf(bm[3])) << 16);
                *(u32x2*)(st + (size_t)(c0 + j) * 16384) = o;
                s0 = s0 * __expf(bl[0]) + bf2f((unsigned short)(w.x & 0xffffu)); s1 = s1 * __expf(bl[1]) + bf2f((unsigned short)(w.x >> 16));
                s2 = s2 * __expf(bl[2]) + bf2f((unsigned short)(w.y & 0xffffu)); s3 = s3 * __expf(bl[3]) + bf2f((unsigned short)(w.y >> 16)); } }
    }
}
DI void hgrn_out_unit(const Frame& F, int un, const float* ng) { PHASE_IDS
    const h16* P = wsp<h16>(F, WS_PROJ); const unsigned short* KT = wsp<unsigned short>(F, WS_HGK); const unsigned short* QT = wsp<unsigned short>(F, WS_HGQ);
    const unsigned short* ST = wsp<unsigned short>(F, WS_HGST); h16* MIX = wsp<h16>(F, WS_H16);
    const int r = lane & 31, hh = lane >> 5;
    const int tt = un & 1, bhc = un >> 1, c = bhc & 63, bh = bhc >> 6, b = bh >> 2, h = bh & 3;
    const size_t tok0 = ((size_t)b * 64 + c) * 64, tq = tok0 + 32 * tt + r;
    bf16x8 qf[8];
#pragma unroll
    for (int s8 = 0; s8 < 8; ++s8) qf[s8] = *(const bf16x8*)(QT + tq * DG + h * 128 + 16 * s8 + 8 * hh);
    f32x16 oacc[4];
#pragma unroll
    for (int mt = 0; mt < 4; ++mt)
#pragma unroll
        for (int i2 = 0; i2 < 16; ++i2) oacc[mt][i2] = 0.f;
    const unsigned short* st = ST + (size_t)bhc * 16384 + (size_t)(4 * r) * 128 + 8 * hh;
#pragma unroll
    for (int s8h = 0; s8h < 8; s8h += 4) { bf16x8 sfa[4][4];
#pragma unroll
        for (int s8 = 0; s8 < 4; ++s8)
#pragma unroll
            for (int mt = 0; mt < 4; ++mt) sfa[s8][mt] = *(const bf16x8*)(st + mt * 128 + 16 * (s8h + s8));
        __builtin_amdgcn_sched_barrier(0);
#pragma unroll
        for (int s8 = 0; s8 < 4; ++s8)
#pragma unroll
            for (int mt = 0; mt < 4; ++mt) oacc[mt] = __builtin_amdgcn_mfma_f32_32x32x16_bf16(sfa[s8][mt], qf[s8h + s8], oacc[mt], 0, 0, 0); }
    for (int st2 = 0; st2 <= tt; ++st2) { f32x16 sacc;
#pragma unroll
        for (int i2 = 0; i2 < 16; ++i2) sacc[i2] = 0.f;
        const unsigned short* kr = KT + (tok0 + 32 * st2 + r) * DG + h * 128 + 8 * hh; const h16* vr = P + (tok0 + 32 * st2 + 4 * hh) * NIN + 1024 + h * 128 + 4 * r;
        bf16x8 kfa[8]; half4 vqa[16];
#pragma unroll
        for (int s8 = 0; s8 < 8; ++s8) kfa[s8] = *(const bf16x8*)(kr + 16 * s8);
#pragma unroll
        for (int jj = 0; jj < 16; ++jj) vqa[jj] = *(const half4*)(vr + (size_t)(16 * (jj >> 3) + 8 * ((jj >> 2) & 1) + (jj & 3)) * NIN);
        __builtin_amdgcn_sched_barrier(0);
#pragma unroll
        for (int s8 = 0; s8 < 8; ++s8) sacc = __builtin_amdgcn_mfma_f32_32x32x16_bf16(kfa[s8], qf[s8], sacc, 0, 0, 0);
        const bool diag = (st2 == tt); half8 wf[2];
#pragma unroll
        for (int i2 = 0; i2 < 16; ++i2) { const int kc = (i2 & 3) + 8 * (i2 >> 2) + 4 * hh; const bool valid = !diag || (kc <= r); wf[i2 >> 3][i2 & 7] = (h16)(valid ? sacc[i2] : 0.f); }
#pragma unroll
        for (int s2 = 0; s2 < 2; ++s2) { half8 vf[4];
#pragma unroll
            for (int jj = 0; jj < 8; ++jj) { const half4 v4 = vqa[8 * s2 + jj]; vf[0][jj] = v4[0]; vf[1][jj] = v4[1]; vf[2][jj] = v4[2]; vf[3][jj] = v4[3]; }
#pragma unroll
            for (int mt = 0; mt < 4; ++mt) oacc[mt] = __builtin_amdgcn_mfma_f32_32x32x16_f16(vf[mt], wf[s2], oacc[mt], 0, 0, 0); }
    }
    float q = 0.f;
#pragma unroll
    for (int mt = 0; mt < 4; ++mt)
#pragma unroll
        for (int i2 = 0; i2 < 16; ++i2) q += oacc[mt][i2] * oacc[mt][i2];
    q += __shfl_xor(q, 32);
    const float rr = rsqrtf_(q * (1.f / 128.f) + opq_f(RMS_EPS));
    const h16* gp = P + tq * NIN + 1536 + h * 128; h16* orow = MIX + tq * DM + h * 128;
    half4 g4a[16]; f32x4 n4a[16];
#pragma unroll
    for (int i2 = 0; i2 < 16; ++i2) { const int v0 = 4 * ((i2 & 3) + 8 * (i2 >> 2) + 4 * hh); g4a[i2] = *(const half4*)(gp + v0); n4a[i2] = *(const f32x4*)(ng + h * 128 + v0); }
#pragma unroll
    for (int i2 = 0; i2 < 16; ++i2) { const int v0 = 4 * ((i2 & 3) + 8 * (i2 >> 2) + 4 * hh);
        float o[4];
#pragma unroll
        for (int mt = 0; mt < 4; ++mt) o[mt] = oacc[mt][i2] * rr * n4a[i2][mt] * siluf_((float)g4a[i2][mt]);
        u32x2 w; w.x = pkh(o[0], o[1]); w.y = pkh(o[2], o[3]); *(u32x2*)(orow + v0) = w; }
}
DI void finalize_rows(const Frame& F, int l) { PHASE_IDS
    h16* MIX = wsp<h16>(F, WS_H16);
    const h16* RAW = wsp<h16>(F, WS_RWRAW); const unsigned char* REC = wsp<unsigned char>(F, WS_RWREC); const float* BON = wsp<float>(F, WS_RWBON); const h16* GG = wsp<h16>(F, WS_LR16);
    const int c0 = 8 * lane, hd = lane >> 3, kcol = c0 & 63;
    float gg[8], gb[8];
#pragma unroll
    for (int j = 0; j < 8; ++j) { gg[j] = inp(F, I_RWGNG)[l * DG + c0 + j]; gb[j] = inp(F, I_RWGNB)[l * DG + c0 + j]; }
    for (int row0 = gw; row0 < M; row0 += 2 * NGW) { half8 xr[2], gr[2]; u32x4 vr2[2]; float bsr[2];
#pragma unroll
        for (int u = 0; u < 2; ++u) { const int row = (row0 + u * NGW) < M ? (row0 + u * NGW) : M - 1; const int b = row >> 12, sq = row & (SEQ - 1);
            xr[u] = *(const half8*)(RAW + (size_t)row * DG + c0); gr[u] = *(const half8*)(GG + (size_t)row * 1536 + 1024 + c0);
            vr2[u] = *(const u32x4*)(REC + ((size_t)(b * 8 + hd) * 256 + (sq >> 4)) * RR_BYTES + RR_VV + ((sq & 15) * 64 + kcol) * 2); bsr[u] = BON[(size_t)row * 8 + hd]; }
#pragma unroll
        for (int u = 0; u < 2; ++u) { const int row = row0 + u * NGW; if (row < M) {
        float x[8], g[8]; h8_to_f(xr[u], x); h8_to_f(gr[u], g); const u32x4 vv = vr2[u]; const float bs = bsr[u];
        const float v[8] = {bf2f((unsigned short)(vv.x & 0xffffu)), bf2f((unsigned short)(vv.x >> 16)), bf2f((unsigned short)(vv.y & 0xffffu)), bf2f((unsigned short)(vv.y >> 16)),
                            bf2f((unsigned short)(vv.z & 0xffffu)), bf2f((unsigned short)(vv.z >> 16)), bf2f((unsigned short)(vv.w & 0xffffu)), bf2f((unsigned short)(vv.w >> 16))};
        float sx = 0.f;
#pragma unroll
        for (int j = 0; j < 8; ++j) sx += x[j];
        sx = sum8(sx); const float mean = sx * (1.f / 64.f); float qq = 0.f;
#pragma unroll
        for (int j = 0; j < 8; ++j) { x[j] -= mean; qq += x[j] * x[j]; }
        qq = sum8(qq); const float rstd = rsqrtf_(qq * (1.f / 64.f) + opq_f(GN_EPS)); float o[8];
#pragma unroll
        for (int j = 0; j < 8; ++j) o[j] = (x[j] * rstd * gg[j] + gb[j] + bs * v[j]) * g[j];
        *(half8*)(MIX + (size_t)row * DM + 1536 + c0) = f_to_h8(o); } }
    }
}

constexpr int PH_PER_LAYER = 11, N_PHASES = 2 + DEPTH * PH_PER_LAYER;
__global__ void __launch_bounds__(NWAVES * 64, 2) hse_fwd(Args args) {
    extern __shared__ __attribute__((aligned(16))) unsigned char lds_raw[];
    Frame F;
    F.lds = (LAS unsigned char*)lds_raw;
    const int G = gridDim.x, wave = __builtin_amdgcn_readfirstlane(threadIdx.x >> 6);
    F.ws = args.ws; F.out = args.out; F.wave = wave;
    volatile LAS unsigned* MISC = (volatile LAS unsigned*)(F.lds + MISC_OFF);
    if (threadIdx.x < 16) MISC[threadIdx.x] = 0u;
    __syncthreads();
#if MK_LAUNCH_MODE == 0
    XcdBarrier bar = xcd_barrier_post((unsigned*)(F.ws + WS_CTL) + CW_BAR, MISC + 8, wave);
#define GRID_BAR() xcd_barrier(bar)
#else
#define GRID_BAR() do {} while (0)
#endif
    const int lo = args.ph_lo, hi = args.ph_hi;
#define IN(k) (lo <= (k) && (k) < hi)
#define SEAM(k) do { if (IN((k) + 1)) GRID_BAR(); } while (0)
#define MOD wsp<float>(F, WS_MOD)
#define X wsp<h16>(F, WS_X)
#define H16 wsp<h16>(F, WS_H16)
#define PROJ wsp<h16>(F, WS_PROJ)
    LAS unsigned char* ring = F.lds;

    if (PHE(11) && IN(0)) { p0_mod(F); s5_pow_tables(F, 0); convert_weights(F, 0, 2, wave, 8, wave * 16384); SEAM(0); }
    if (PHE(12) && IN(1)) { modulate_rows(F, inp(F, I_X), MOD, 0, H16); convert_weights(F, 0, 5, wave, 8, wave * 16384); SEAM(1); }

    for (int l = 0; l < DEPTH; ++l) {
        const int pb = 2 + l * PH_PER_LAYER;
#define modl (MOD + (size_t)l * BATCH * MODW)
        if (PHE(0) && IN(pb + 0)) { REPB(0, pg8::Gemm g{H16, wsp<h16>(F, WS_WIN), DM, DM, DM, 0, 0}; pg8::StaticOrder S; S.init(M, NIN, G, opq_bid());
            pg8::EpiProj E{PROJ, wsp<h16>(F, WS_UG)}; pg8::gemm_phase<pg8::EpiProj, pg8::StaticOrder, true>(ring, g, S, E, wave););
            SEAM(pb + 0); }
        if (PHE(1) && IN(pb + 1)) { REPB(1, { pg8::Gemm g{wsp<h16>(F, WS_UG), wsp<h16>(F, WS_S5T1), S5K3, 512, 512, (long)S5NC * S5K3, 256L * 512}; pg8::GroupOrder S; S.init(4, 1, 32, G, opq_bid());
                pg8::EpiS5h E{wsp<float>(F, WS_HLOC)}; if (PHE(15)) pg8::gemm_phase<pg8::EpiS5h, pg8::GroupOrder, true>(ring, g, S, E, wave); }
            __syncthreads();
            if (PHE(14)) { prep_rows(F, l); hgrn_prep(F, l); });
            SEAM(pb + 1); }
        if (PHE(2) && IN(pb + 2)) { REPB(2, { pg8::Gemm g{wsp<h16>(F, WS_RWA), wsp<h16>(F, WS_LRT), 256, 256, 256, 0, 0}; pg8::StaticOrder S; S.init(M, 1536, G, opq_bid());
                pg8::EpiLR E{wsp<h16>(F, WS_LR16)};
                if (PHE(17)) pg8::gemm_phase<pg8::EpiLR, pg8::StaticOrder, true>(ring, g, S, E, wave); }
            if (PHE(16)) { s5_chunk_scan(F, l); hgrn_loc_units(F); });
            SEAM(pb + 2); }
        if (PHE(3) && IN(pb + 3)) { REPB(3, { pg8::Gemm g{wsp<h16>(F, WS_UG), wsp<h16>(F, WS_S5T3), S5K3, S5K3, S5K3, (long)S5NC * S5K3, 512L * S5K3}; pg8::GroupOrder S; S.init(4, 2, 32, G, opq_bid());
                pg8::EpiS5y E{PROJ, inp(F, I_S5D) + l * DG, wsp<h16>(F, WS_Y16)}; pg8::gemm_phase<pg8::EpiS5y, pg8::GroupOrder, true>(ring, g, S, E, wave); }
            rwkv_chunk_prep(F, l); hgrn_state_scan(F); if (l + 1 < DEPTH) s5_pow_tables(F, l + 1); rwkv_sync_zero(F););
            SEAM(pb + 3); }
        if (PHE(4) && IN(pb + 4)) { REPB(4, if (wave == 0) rwkv_scan_consumer(F);
            else if (wave == 4 || wave == 5) rwkv_scan_loader(F, wave - 4);
            else { const int ws5 = wave < 4 ? wave - 1 : wave - 3; const float* ng = inp(F, I_HGNG) + l * DG;
                for (int un = opq_bid() * 5 + ws5; un < BATCH * 4 * 64 * 2; un += G * 5) hgrn_out_unit(F, un, ng);
                if (PHE(13)) attention_units(F, ws5, 5); if (l + 1 < DEPTH) convert_weights(F, l + 1, 4, ws5, 5, 0); });
            SEAM(pb + 4); }
        if (PHE(5) && IN(pb + 5)) { REPB(5, { pg8::Gemm g{wsp<h16>(F, WS_Y16), wsp<h16>(F, WS_GLU), DG, DG, DG, 0, 0}; pg8::StaticOrder S; S.init(M, DG, G, opq_bid());
                pg8::EpiGLU E{wsp<h16>(F, WS_Y16), inp(F, I_GLUB) + l * DG, H16}; pg8::gemm_phase<pg8::EpiGLU, pg8::StaticOrder, true>(ring, g, S, E, wave); }
            finalize_rows(F, l););
            SEAM(pb + 5); }
        if (PHE(6) && IN(pb + 6)) { REPB(6, pg8::Gemm g{H16, wsp<h16>(F, WS_WOUT), DM, DM, DM, 0, 0}; pg8::StaticOrder S; S.init(M, DM, G, opq_bid());
            pg8::EpiRes E{inp(F, I_X), X, X, modl + 2 * DM, l == 0 ? (const float*)nullptr : wsp<float>(F, WS_LNST), inp(F, I_LN2G) + (l > 0 ? l - 1 : 0) * DM, inp(F, I_LN2B) + (l > 0 ? l - 1 : 0) * DM};
            pg8::gemm_phase<pg8::EpiRes, pg8::StaticOrder, true>(ring, g, S, E, wave););
            SEAM(pb + 6); }
        if (PHE(7) && IN(pb + 7)) { REPB(7, ln_rows(F, X, (float*)nullptr, inp(F, I_LN1G) + l * DM, inp(F, I_LN1B) + l * DM, modl, 3, H16, wsp<float>(F, WS_LNST)););
            SEAM(pb + 7); }
        if (PHE(8) && IN(pb + 8)) { REPB(8, pg8::Gemm g{H16, wsp<h16>(F, WS_W13), DM, DM, DM, 0, 0}; pg8::StaticOrder S; S.init(M, 2 * DFF, G, opq_bid());
            pg8::EpiSwiGLU E{PROJ}; pg8::gemm_phase<pg8::EpiSwiGLU, pg8::StaticOrder, true>(ring, g, S, E, wave););
            SEAM(pb + 8); }
        if (PHE(9) && IN(pb + 9)) { REPB(9, pg8::Gemm g{PROJ, wsp<h16>(F, WS_W2), DFF, DFF, DFF, 0, 0}; pg8::StaticOrder S; S.init(M, DM, G, opq_bid());
            pg8::EpiRes E{(const float*)nullptr, X, X, modl + 5 * DM, wsp<float>(F, WS_LNST), inp(F, I_LN1G) + l * DM, inp(F, I_LN1B) + l * DM}; pg8::gemm_phase<pg8::EpiRes, pg8::StaticOrder, true>(ring, g, S, E, wave););
            SEAM(pb + 9); }
        if (PHE(10) && IN(pb + 10)) { REPB(10, const bool lastl = (l == DEPTH - 1);
            ln_rows(F, X, lastl ? F.out : (float*)nullptr, inp(F, I_LN2G) + l * DM, inp(F, I_LN2B) + l * DM, modl + (size_t)BATCH * MODW, 0, lastl ? (h16*)nullptr : H16, lastl ? (float*)nullptr : wsp<float>(F, WS_LNST));
            if (!lastl) { __syncthreads(); convert_weights(F, l + 1, 3, wave, 8, wave * 16384); });
            SEAM(pb + 10); }
    }
#undef IN
#undef SEAM
#undef MOD
#undef X
#undef H16
#undef PROJ
#undef modl
}

extern "C" void kernel_launch(void* const* d_in, const int* in_sizes, int n_in, void* d_out, int out_size, void* d_ws, size_t ws_size, hipStream_t stream) {
    static int grid = 0;
    if (grid == 0) {
        if (n_in != 36 || in_sizes[0] != M * DM || out_size != M * DM || ws_size < WS_END) { fprintf(stderr, "kernel_launch: unexpected shapes (n_in %d, in0 %d, out %d, ws %zu)\n", n_in, n_in > 0 ? in_sizes[0] : -1, out_size, ws_size); grid = -1; return; }
        int dev = 0, cus = 0, per_cu = 0;
        if (hipGetDevice(&dev) != hipSuccess || hipDeviceGetAttribute(&cus, hipDeviceAttributeMultiprocessorCount, dev) != hipSuccess) { grid = -1; return; }
        if (hipFuncSetAttribute((const void*)hse_fwd, hipFuncAttributeMaxDynamicSharedMemorySize, LDS_BYTES) != hipSuccess) { fprintf(stderr, "kernel_launch: hipFuncSetAttribute failed\n"); grid = -1; return; }
        if (hipOccupancyMaxActiveBlocksPerMultiprocessor(&per_cu, (const void*)hse_fwd, NWAVES * 64, LDS_BYTES) != hipSuccess || per_cu < 1) { fprintf(stderr, "kernel_launch: occupancy query reports %d\n", per_cu); }
        (void)hipGetLastError();
        grid = cus;
    }
    if (grid < 0) return;
    if (hipMemsetAsync((char*)d_ws + WS_CTL, 0, CTL_ZERO_BYTES, stream) != hipSuccess) return;
    Args a{};
    for (int i = 0; i < 36; ++i) a.in[i] = (const float*)d_in[i];
    a.out = (float*)d_out; a.ws = (unsigned char*)d_ws;
#if MK_LAUNCH_MODE == 0
    a.ph_lo = 0; a.ph_hi = N_PHASES;
    hipLaunchKernelGGL(hse_fwd, dim3(grid), dim3(NWAVES * 64), LDS_BYTES, stream, a);
#else
    for (int p = 0; p < N_PHASES; ++p) { a.ph_lo = p; a.ph_hi = p + 1; hipLaunchKernelGGL(hse_fwd, dim3(grid), dim3(NWAVES * 64), LDS_BYTES, stream, a); }
#endif
}
```
